# Optimizing an MI355X kernel written in HIP

```python
import jax, jax.numpy as jnp
from jax import lax
import numpy as np

D_MODEL = 1024
BATCH = 1
SEQ = 16384
DEPTH = 2

CHUNK = 64
Q_BLOCK = 128
N_MEM = 256
EPS = 1e-6
FOX_HEADS = 8
FOX_HEAD_DIM = 64
FOX_WIDTH = FOX_HEADS * FOX_HEAD_DIM
GDN_HEADS = 4
GDN_HEAD_DIM = 128
GDN_WIDTH = GDN_HEADS * GDN_HEAD_DIM
CONV_K = 4
MEM_HEADS = 4
MEM_HEAD_DIM = 128
MEM_WIDTH = MEM_HEADS * MEM_HEAD_DIM
N_BRANCH = 3
BRANCH_WIDTH = 512

IN_SIZES = (FOX_WIDTH, FOX_WIDTH, FOX_WIDTH, FOX_HEADS, FOX_WIDTH,
            GDN_WIDTH, GDN_WIDTH, GDN_WIDTH, GDN_HEADS, GDN_HEADS, GDN_WIDTH,
            MEM_WIDTH, MEM_WIDTH,
            N_BRANCH * D_MODEL)
N_IN = sum(IN_SIZES)

kernel_name = 'hybrid_fox_gdn_memory_gated_merge'


def _split_cols(z, sizes):
    idx = []
    acc = 0
    for s in sizes[:-1]:
        acc += s
        idx.append(acc)
    return jnp.split(z, idx, axis=-1)


def rms_norm(x, g):
    xf = x.astype(jnp.float32)
    y = xf * lax.rsqrt(jnp.mean(xf * xf, axis=-1, keepdims=True) + EPS)
    return (y * g.astype(jnp.float32)).astype(x.dtype)


def l2_normalize(x):
    return x * lax.rsqrt(jnp.sum(x * x, axis=-1, keepdims=True) + EPS)


def forgetting_attention(q, k, v, f_logit):
    B, S, H, d = q.shape
    log_f = jax.nn.log_sigmoid(f_logit.astype(jnp.float32))
    F = jnp.cumsum(log_f, axis=1).transpose(0, 2, 1)
    nb = S // Q_BLOCK
    pos = jnp.arange(S)
    q_blocks = q.reshape(B, nb, Q_BLOCK, H, d).swapaxes(0, 1)
    F_blocks = F.reshape(B, H, nb, Q_BLOCK).transpose(2, 0, 1, 3)
    p_blocks = pos.reshape(nb, Q_BLOCK)
    scale = d ** -0.5

    def block(args):
        q_blk, F_blk, p_blk = args
        s = jnp.einsum('bqhd,bkhd->bhqk', q_blk, k,
                       preferred_element_type=jnp.float32) * scale
        s = s + F_blk[..., :, None] - F[:, :, None, :]
        s = jnp.where(pos[None, None, None, :] <= p_blk[None, None, :, None], s, -jnp.inf)
        p = jax.nn.softmax(s, axis=-1)
        return jnp.einsum('bhqk,bkhd->bqhd', p.astype(v.dtype), v)

    o = lax.map(block, (q_blocks, F_blocks, p_blocks))
    return o.swapaxes(0, 1).reshape(B, S, H * d)


def causal_dwconv(x, w):
    K = w.shape[0]
    return lax.conv_general_dilated(
        x, w[:, None, :].astype(x.dtype), window_strides=(1,),
        padding=[(K - 1, 0)], dimension_numbers=('NWC', 'WIO', 'NWC'),
        feature_group_count=x.shape[-1])


def gated_delta_rule(q, k, v, g, beta):
    B, S, H, dk = q.shape
    dv = v.shape[-1]
    N = S // CHUNK
    C = CHUNK

    def chunks(t):
        t = t.reshape((B, N, C, H) + t.shape[3:])
        return jnp.moveaxis(t, 3, 1)

    qc, kc, vc = chunks(q), chunks(k), chunks(v)
    gc, bc = chunks(g), chunks(beta)
    G = jnp.cumsum(gc, axis=-1)
    tril_incl = jnp.tril(jnp.ones((C, C), dtype=bool))
    tril_strict = jnp.tril(jnp.ones((C, C), dtype=bool), -1)
    gamma = jnp.exp(jnp.where(tril_incl, G[..., :, None] - G[..., None, :], -jnp.inf))
    kb = kc * bc[..., None]
    A = jnp.where(tril_strict, jnp.einsum('bhncd,bhnsd->bhncs', kb, kc) * gamma, 0.0)
    eye = jnp.eye(C, dtype=A.dtype)
    rhs = jnp.concatenate([vc * bc[..., None], kb * jnp.exp(G)[..., None]], axis=-1)
    sol = lax.linalg.triangular_solve(A + eye, rhs, left_side=True, lower=True,
                                      unit_diagonal=True)
    u, w = sol[..., :dv], sol[..., dv:]
    a_qk = jnp.einsum('bhncd,bhnsd->bhncs', qc, kc) * gamma
    q_dec = qc * jnp.exp(G)[..., None]
    G_last = G[..., -1]
    k_dec = kc * jnp.exp(G_last[..., None] - G)[..., None]

    def step(state, inp):
        dq, kd, uu, ww, aqk, gl = inp
        v_new = uu - jnp.einsum('bhcd,bhde->bhce', ww, state)
        o = (jnp.einsum('bhcd,bhde->bhce', dq, state)
             + jnp.einsum('bhcs,bhse->bhce', aqk, v_new))
        state = state * jnp.exp(gl)[..., None, None] + jnp.einsum('bhcd,bhce->bhde', kd, v_new)
        return state, o

    xs = tuple(jnp.moveaxis(t, 2, 0) for t in (q_dec, k_dec, u, w, a_qk, G_last))
    state0 = jnp.zeros((B, H, dk, dv), jnp.float32)
    _, o = lax.scan(step, state0, xs)
    o = jnp.moveaxis(o, 0, 2)
    return jnp.moveaxis(o, 1, 3).reshape(B, S, H, dv)


def hybrid_layer(x, mem, norm_g, w_in, b_fg, b_merge, conv_w, a_log, dt_bias,
                 gdn_norm_g, mem_norm_g, w_mem_kv, w_branch, w_out):
    B, S, D = x.shape
    dt = x.dtype
    h = rms_norm(x, norm_g)
    z = h @ w_in
    (aq, ak, av, af, az, bq, bk, bv, ba, bb, bz, mq, mz, gates) = _split_cols(z, IN_SIZES)

    o_a = forgetting_attention(aq.reshape(B, S, FOX_HEADS, FOX_HEAD_DIM),
                               ak.reshape(B, S, FOX_HEADS, FOX_HEAD_DIM),
                               av.reshape(B, S, FOX_HEADS, FOX_HEAD_DIM),
                               af + b_fg)
    y_a = (o_a * jax.nn.silu(az)).astype(dt)

    qkv = jax.nn.silu(causal_dwconv(jnp.concatenate([bq, bk, bv], axis=-1), conv_w))
    gq, gk, gv = jnp.split(qkv.astype(jnp.float32), 3, axis=-1)
    gq = l2_normalize(gq.reshape(B, S, GDN_HEADS, GDN_HEAD_DIM)) * (GDN_HEAD_DIM ** -0.5)
    gk = l2_normalize(gk.reshape(B, S, GDN_HEADS, GDN_HEAD_DIM))
    gv = gv.reshape(B, S, GDN_HEADS, GDN_HEAD_DIM)
    g_log = -jnp.exp(a_log.astype(jnp.float32)) * jax.nn.softplus(
        ba.astype(jnp.float32) + dt_bias.astype(jnp.float32))
    beta = jax.nn.sigmoid(bb.astype(jnp.float32))
    o_b = gated_delta_rule(gq, gk, gv, g_log, beta)
    y_b = (rms_norm(o_b, gdn_norm_g).reshape(B, S, GDN_WIDTH) * jax.nn.silu(bz)).astype(dt)

    mem_n = rms_norm(mem, mem_norm_g)
    mk, mv = jnp.split(mem_n @ w_mem_kv, 2, axis=-1)
    M = mem.shape[1]
    mk = mk.reshape(B, M, MEM_HEADS, MEM_HEAD_DIM)
    mv = mv.reshape(B, M, MEM_HEADS, MEM_HEAD_DIM)
    s_m = jnp.einsum('bshd,bmhd->bhsm', mq.reshape(B, S, MEM_HEADS, MEM_HEAD_DIM), mk,
                     preferred_element_type=jnp.float32) * (MEM_HEAD_DIM ** -0.5)
    p_m = jax.nn.softmax(s_m, axis=-1)
    o_m = jnp.einsum('bhsm,bmhd->bshd', p_m.astype(mv.dtype), mv).reshape(B, S, MEM_WIDTH)
    y_m = (o_m * jax.nn.silu(mz)).astype(dt)

    ys = jnp.stack([y_a, y_b, y_m], axis=2)
    proj = jnp.einsum('bsnc,ncd->bsnd', ys, w_branch)
    gate = jax.nn.sigmoid(gates + b_merge).reshape(B, S, N_BRANCH, D)
    merged = jnp.sum(gate * proj, axis=2)
    return x + merged @ w_out


def setup_inputs(seed: int = 0) -> dict:
    key = jax.random.key(seed)
    ks = jax.random.split(key, 16)
    f32 = jnp.float32
    x = jax.random.normal(ks[0], (BATCH, SEQ, D_MODEL), f32)
    mem = jax.random.normal(ks[1], (BATCH, N_MEM, D_MODEL), f32)
    norm_g = 1.0 + 0.02 * jax.random.normal(ks[2], (DEPTH, D_MODEL), f32)
    w_in = jax.random.normal(ks[3], (DEPTH, D_MODEL, N_IN), f32) * (D_MODEL ** -0.5)
    b_fg = 1.0 + 3.0 * jax.random.uniform(ks[4], (DEPTH, FOX_HEADS), f32)
    b_merge = 0.02 * jax.random.normal(ks[5], (DEPTH, N_BRANCH * D_MODEL), f32)
    conv_w = jax.random.normal(ks[6], (DEPTH, CONV_K, 3 * GDN_WIDTH), f32) * (CONV_K ** -0.5)
    a_log = jnp.log(jax.random.uniform(ks[7], (DEPTH, GDN_HEADS), f32, 1.0, 16.0))
    dt0 = jnp.exp(jax.random.uniform(ks[8], (DEPTH, GDN_HEADS), f32,
                                     float(np.log(1e-3)), float(np.log(1e-1))))
    dt_bias = dt0 + jnp.log(-jnp.expm1(-dt0))
    gdn_norm_g = 1.0 + 0.02 * jax.random.normal(ks[9], (DEPTH, GDN_HEAD_DIM), f32)
    mem_norm_g = 1.0 + 0.02 * jax.random.normal(ks[10], (DEPTH, D_MODEL), f32)
    w_mem_kv = jax.random.normal(ks[11], (DEPTH, D_MODEL, 2 * MEM_WIDTH), f32) * (D_MODEL ** -0.5)
    w_branch = jax.random.normal(ks[12], (DEPTH, N_BRANCH, BRANCH_WIDTH, D_MODEL), f32) * (BRANCH_WIDTH ** -0.5)
    w_out = jax.random.normal(ks[13], (DEPTH, D_MODEL, D_MODEL), f32) * (0.5 * D_MODEL ** -0.5)
    final_norm_g = 1.0 + 0.02 * jax.random.normal(ks[14], (D_MODEL,), f32)
    return {'x': x, 'mem': mem, 'norm_g': norm_g, 'w_in': w_in, 'b_fg': b_fg,
            'b_merge': b_merge, 'conv_w': conv_w, 'a_log': a_log, 'dt_bias': dt_bias,
            'gdn_norm_g': gdn_norm_g, 'mem_norm_g': mem_norm_g, 'w_mem_kv': w_mem_kv,
            'w_branch': w_branch, 'w_out': w_out, 'final_norm_g': final_norm_g}


def reference(x, mem, norm_g, w_in, b_fg, b_merge, conv_w, a_log, dt_bias,
              gdn_norm_g, mem_norm_g, w_mem_kv, w_branch, w_out, final_norm_g):
    for l in range(DEPTH):
        x = hybrid_layer(x, mem, norm_g[l], w_in[l], b_fg[l], b_merge[l], conv_w[l],
                         a_log[l], dt_bias[l], gdn_norm_g[l], mem_norm_g[l],
                         w_mem_kv[l], w_branch[l], w_out[l])
    return rms_norm(x, final_norm_g)
```

```cpp
#include <hip/hip_runtime.h>
#include <hip/hip_cooperative_groups.h>
#include <cstdio>
#include <cstdint>
namespace cg = cooperative_groups;

typedef unsigned short bf16_t;
typedef short bf16x8 __attribute__((ext_vector_type(8)));
typedef float f32x4 __attribute__((ext_vector_type(4)));
typedef float f32x16 __attribute__((ext_vector_type(16)));
typedef unsigned u32x4 __attribute__((ext_vector_type(4)));
typedef unsigned u32x2 __attribute__((ext_vector_type(2)));

#define SEQ 16384
#define DM 1024
#define NIN 8208
#define EPSV 1e-6f

#define OFF_WIN   0ull
#define OFF_WBR   16777216ull
#define OFF_WOUT  19922944ull
#define OFF_WMEM  22020096ull
#define OFF_H     24117248ull
#define OFF_BRAW  57671680ull
#define OFF_AQ    (OFF_BRAW)
#define OFF_AK    (OFF_BRAW + 16777216ull)
#define OFF_AVT   (OFF_BRAW + 33554432ull)
#define OFF_MERGED (OFF_BRAW)
#define OFF_GDN   108003328ull
#define OFF_MQ    183500800ull
#define OFF_SZ    200278016ull
#define OFF_F     250609664ull
#define OFF_GLOG  (OFF_F + 524288ull)
#define OFF_BETA  (OFF_GLOG + 262144ull)
#define OFF_SSQ   (OFF_BETA + 262144ull)
#define OFF_MEMN  (OFF_SSQ + 262144ull)
#define OFF_MK    (OFF_MEMN + 524288ull)
#define OFF_MVT   (OFF_MK + 262144ull)
#define OFF_EXPGL (OFF_MVT + 262144ull)
#define OFF_CTR   (OFF_EXPGL + 4096ull)
#define GDN_ITEM 73728

#define LDS_BYTES 69632

struct Params {
    const float* x; const float* mem; const float* norm_g; const float* w_in; const float* b_fg; const float* b_merge;
    const float* conv_w; const float* a_log; const float* dt_bias; const float* gdn_norm_g; const float* mem_norm_g;
    const float* w_mem_kv; const float* w_branch; const float* w_out; const float* final_norm_g;
    float* out; unsigned char* ws;
};

__device__ __forceinline__ int ltid() { int t = __builtin_amdgcn_workitem_id_x(); asm volatile("" : "+v"(t)); return t; }
__device__ __forceinline__ int lbid() { int t = __builtin_amdgcn_workgroup_id_x(); asm volatile("" : "+s"(t)); return t; }
__device__ __forceinline__ float bf2f(bf16_t b) { return __uint_as_float(((unsigned)b) << 16); }
__device__ __forceinline__ bf16_t f2bf(float f) { unsigned u = __float_as_uint(f); u += 0x7fffu + ((u >> 16) & 1u); return (bf16_t)(u >> 16); }
__device__ __forceinline__ unsigned pack2(float lo, float hi) { return (unsigned)f2bf(lo) | ((unsigned)f2bf(hi) << 16); }
__device__ __forceinline__ u32x2 pack4(f32x4 v) { u32x2 r; r.x = pack2(v[0], v[1]); r.y = pack2(v[2], v[3]); return r; }
__device__ __forceinline__ float lo16(unsigned u) { return __uint_as_float(u << 16); }
__device__ __forceinline__ float hi16(unsigned u) { return __uint_as_float(u & 0xffff0000u); }
__device__ __forceinline__ f32x4 mfma16(bf16x8 a, bf16x8 b, f32x4 c) { return __builtin_amdgcn_mfma_f32_16x16x32_bf16(a, b, c, 0, 0, 0); }
__device__ __forceinline__ f32x16 mfma32(bf16x8 a, bf16x8 b, f32x16 c) { return __builtin_amdgcn_mfma_f32_32x32x16_bf16(a, b, c, 0, 0, 0); }
__device__ __forceinline__ float sigmoidf_(float x) { return 1.0f / (1.0f + __expf(-x)); }
__device__ __forceinline__ float siluf_(float x) { return x / (1.0f + __expf(-x)); }
__device__ __forceinline__ float softplusf_(float x) { return fmaxf(x, 0.f) + log1pf(expf(-fabsf(x))); }
__device__ __forceinline__ float wave_sum(float v) {
#pragma unroll
    for (int o = 32; o >= 1; o >>= 1) v += __shfl_xor(v, o);
    return v;
}

__device__ __forceinline__ void gemm_acc(const bf16_t* __restrict__ A, int lda, const bf16_t* __restrict__ B, int ldb, int K,
                                         unsigned char* lds, f32x4 (&acc)[4][4]) {
    bf16_t* As = (bf16_t*)lds; bf16_t* Bs = As + 128 * 72;
    const int tid = ltid(), lane = tid & 63, wid = tid >> 6, wr = wid >> 1, wc = wid & 1, lr = lane & 15, lg = lane >> 4;
    u32x4 ra[4], rb[4];
    const int nk = K >> 6;
#pragma unroll
    for (int i = 0; i < 4; ++i) { const int c = tid + 256 * i, row = c >> 3, ch = c & 7;
        ra[i] = *(const u32x4*)(A + (size_t)row * lda + ch * 8); rb[i] = *(const u32x4*)(B + (size_t)row * ldb + ch * 8); }
    for (int kt = 0; kt < nk; ++kt) {
        if (kt) __syncthreads();
#pragma unroll
        for (int i = 0; i < 4; ++i) { const int c = tid + 256 * i, row = c >> 3, ch = c & 7;
            *(u32x4*)(As + row * 72 + ch * 8) = ra[i]; *(u32x4*)(Bs + row * 72 + ch * 8) = rb[i]; }
        __syncthreads();
        if (kt + 1 < nk) {
            const int k0 = (kt + 1) << 6;
#pragma unroll
            for (int i = 0; i < 4; ++i) { const int c = tid + 256 * i, row = c >> 3, ch = c & 7;
                ra[i] = *(const u32x4*)(A + (size_t)row * lda + k0 + ch * 8); rb[i] = *(const u32x4*)(B + (size_t)row * ldb + k0 + ch * 8); }
        }
#pragma unroll
        for (int s = 0; s < 2; ++s) {
            bf16x8 af[4], bfr[4];
#pragma unroll
            for (int i = 0; i < 4; ++i) af[i] = *(const bf16x8*)(As + (wr * 64 + i * 16 + lr) * 72 + s * 32 + lg * 8);
#pragma unroll
            for (int j = 0; j < 4; ++j) bfr[j] = *(const bf16x8*)(Bs + (wc * 64 + j * 16 + lr) * 72 + s * 32 + lg * 8);
#pragma unroll
            for (int i = 0; i < 4; ++i)
#pragma unroll
                for (int j = 0; j < 4; ++j) acc[i][j] = mfma16(bfr[j], af[i], acc[i][j]);
        }
    }
    __syncthreads();
}
#define ZERO_ACC(acc) _Pragma("unroll") for (int i_ = 0; i_ < 4; ++i_) _Pragma("unroll") for (int j_ = 0; j_ < 4; ++j_) acc[i_][j_] = (f32x4){0.f, 0.f, 0.f, 0.f}
#define FOR_ACC(acc, BODY) do { const int lane_ = ltid() & 63, wid_ = ltid() >> 6, wr_ = wid_ >> 1, wc_ = wid_ & 1; \
    _Pragma("unroll") for (int i_ = 0; i_ < 4; ++i_) _Pragma("unroll") for (int j_ = 0; j_ < 4; ++j_) { \
        const int m = wr_ * 64 + i_ * 16 + (lane_ & 15), n = wc_ * 64 + j_ * 16 + 4 * (lane_ >> 4); f32x4& v = acc[i_][j_]; BODY } } while (0)

__device__ __forceinline__ void transpose_tile(const float* __restrict__ src, int ldsrc, int k0, int c0, bf16_t* __restrict__ dst, int lddst, int n0, unsigned char* lds) {
    float* T = (float*)lds;
    const int tid = ltid();
#pragma unroll
    for (int i = 0; i < 16; ++i) { const int k = (tid >> 6) + 4 * i, n = tid & 63; T[k * 65 + n] = src[(size_t)(k0 + k) * ldsrc + c0 + n]; }
    __syncthreads();
#pragma unroll
    for (int i = 0; i < 8; ++i) { const int n = (tid >> 5) + 8 * i, k = 2 * (tid & 31);
        *(unsigned*)(dst + (size_t)(n0 + n) * lddst + k0 + k) = pack2(T[k * 65 + n], T[(k + 1) * 65 + n]); }
    __syncthreads();
}
__device__ __forceinline__ int win_orig_col(int nr) {
    if (nr < 1536) return 2056 + nr;
    if (nr < 3072) return nr - 1536;
    if (nr < 3584) return 4112 + (nr - 3072);
    if (nr < 4096) return 1544 + (nr - 3584);
    if (nr < 4608) return 3600 + (nr - 4096);
    if (nr < 5120) return 4624 + (nr - 4608);
    return 5136 + (nr - 5120);
}

__device__ __forceinline__ void phase_a(const Params& p, int layer, unsigned char* lds) {
    const int tid = ltid(), lane = tid & 63, wid = tid >> 6, bid = lbid(), nb = gridDim.x;
    unsigned char* ws = p.ws;
    const float* xin = layer == 0 ? p.x : p.out;
    const float* w_in = p.w_in + (size_t)layer * DM * NIN;
    {
        float* ssq = (float*)(ws + OFF_SSQ);
        for (int i = bid * 256 + tid; i < 65536; i += nb * 256) ssq[i] = 0.f;
        if (bid == 0 && tid < 64) ((unsigned*)(ws + OFF_CTR))[tid] = 0u;
    }
    float* Wsm = (float*)lds;
    for (int k = tid; k < 1024; k += 256) {
        const float* r = w_in + (size_t)k * NIN;
        f32x4 a0 = *(const f32x4*)(r + 1536), a1 = *(const f32x4*)(r + 1540), b0 = *(const f32x4*)(r + 3592), b1 = *(const f32x4*)(r + 3596);
#pragma unroll
        for (int q = 0; q < 4; ++q) { Wsm[q * 1024 + k] = a0[q]; Wsm[(4 + q) * 1024 + k] = a1[q]; Wsm[(8 + q) * 1024 + k] = b0[q]; Wsm[(12 + q) * 1024 + k] = b1[q]; }
    }
    __syncthreads();
    {
        const float* ng = p.norm_g + layer * DM;
        f32x4 g[4];
#pragma unroll
        for (int i = 0; i < 4; ++i) g[i] = *(const f32x4*)(ng + 4 * lane + 256 * i);
        bf16_t* H = (bf16_t*)(ws + OFF_H);
        float* Fb = (float*)(ws + OFF_F); float* GL = (float*)(ws + OFF_GLOG); float* BT = (float*)(ws + OFF_BETA);
        for (int row = bid * 4 + wid; row < SEQ; row += nb * 4) {
            asm volatile("" ::: "memory");
            f32x4 xv[4]; float ss = 0.f;
#pragma unroll
            for (int i = 0; i < 4; ++i) { xv[i] = *(const f32x4*)(xin + (size_t)row * DM + 4 * lane + 256 * i); ss += xv[i][0] * xv[i][0] + xv[i][1] * xv[i][1] + xv[i][2] * xv[i][2] + xv[i][3] * xv[i][3]; }
            ss = wave_sum(ss);
            const float rstd = rsqrtf(ss * (1.0f / DM) + EPSV);
#pragma unroll
            for (int i = 0; i < 4; ++i) { xv[i] = xv[i] * rstd * g[i]; *(u32x2*)(H + (size_t)row * DM + 4 * lane + 256 * i) = pack4(xv[i]); }
            float myv = 0.f;
#pragma unroll
            for (int c = 0; c < 16; ++c) {
                float d = 0.f;
#pragma unroll
                for (int i = 0; i < 4; ++i) { const f32x4 w = *(const f32x4*)(Wsm + c * 1024 + 4 * lane + 256 * i); d += xv[i][0] * w[0] + xv[i][1] * w[1] + xv[i][2] * w[2] + xv[i][3] * w[3]; }
                d = wave_sum(d);
                if (lane == c) myv = d;
            }
            if (lane < 8) { const float z = myv + p.b_fg[layer * 8 + lane]; Fb[(size_t)lane * SEQ + row] = -softplusf_(-z); }
            else if (lane < 12) { const int hd = lane - 8; GL[(size_t)hd * SEQ + row] = -expf(p.a_log[layer * 4 + hd]) * softplusf_(myv + p.dt_bias[layer * 4 + hd]); }
            else if (lane < 16) { const int hd = lane - 12; BT[(size_t)hd * SEQ + row] = 1.0f / (1.0f + expf(-myv)); }
        }
        const float* mg = p.mem_norm_g + layer * DM;
        bf16_t* MN = (bf16_t*)(ws + OFF_MEMN);
        for (int row = bid * 4 + wid; row < 256; row += nb * 4) {
            f32x4 xv[4]; float ss = 0.f;
#pragma unroll
            for (int i = 0; i < 4; ++i) { xv[i] = *(const f32x4*)(p.mem + (size_t)row * DM + 4 * lane + 256 * i); ss += xv[i][0] * xv[i][0] + xv[i][1] * xv[i][1] + xv[i][2] * xv[i][2] + xv[i][3] * xv[i][3]; }
            ss = wave_sum(ss);
            const float rstd = rsqrtf(ss * (1.0f / DM) + EPSV);
#pragma unroll
            for (int i = 0; i < 4; ++i) { const f32x4 gg = *(const f32x4*)(mg + 4 * lane + 256 * i); xv[i] = xv[i] * rstd * gg; *(u32x2*)(MN + (size_t)row * DM + 4 * lane + 256 * i) = pack4(xv[i]); }
        }
    }
    __syncthreads();
    for (int it = bid; it < 2944; it += nb) {
        if (it < 2048) { const int nt = it >> 4, kt = it & 15; transpose_tile(w_in, NIN, kt * 64, win_orig_col(nt * 64), (bf16_t*)(ws + OFF_WIN), 1024, nt * 64, lds); }
        else if (it < 2432) { const int j = it - 2048, br = j >> 7, r = j & 127, nt = r >> 3, kt = r & 7;
            transpose_tile(p.w_branch + ((size_t)layer * 3 + br) * 512 * 1024, 1024, kt * 64, nt * 64, (bf16_t*)(ws + OFF_WBR) + (size_t)br * 1024 * 512, 512, nt * 64, lds); }
        else if (it < 2688) { const int j = it - 2432, nt = j >> 4, kt = j & 15; transpose_tile(p.w_out + (size_t)layer * DM * DM, DM, kt * 64, nt * 64, (bf16_t*)(ws + OFF_WOUT), 1024, nt * 64, lds); }
        else { const int j = it - 2688, nt = j >> 4, kt = j & 15; transpose_tile(p.w_mem_kv + (size_t)layer * DM * DM, DM, kt * 64, nt * 64, (bf16_t*)(ws + OFF_WMEM), 1024, nt * 64, lds); }
    }
}

__device__ __forceinline__ void cumsum_head(float* F, unsigned char* lds) {
    double* part = (double*)lds;
    const int tid = ltid();
    double s = 0.0;
    for (int i = 0; i < 64; ++i) s += (double)F[tid * 64 + i];
    part[tid] = s;
    __syncthreads();
    if (tid == 0) { double run = 0.0; for (int i = 0; i < 256; ++i) { const double t = part[i]; part[i] = run; run += t; } }
    __syncthreads();
    double run = part[tid];
    for (int i = 0; i < 64; ++i) { run += (double)F[tid * 64 + i]; F[tid * 64 + i] = (float)run; }
    __syncthreads();
}

__device__ __forceinline__ void phase_b1(const Params& p, unsigned char* lds) {
    unsigned char* ws = p.ws; const int bid = lbid(), nb = gridDim.x;
    const bf16_t* H = (const bf16_t*)(ws + OFF_H); const bf16_t* WIN = (const bf16_t*)(ws + OFF_WIN);
    const bf16_t* WM = (const bf16_t*)(ws + OFF_WMEM); const bf16_t* MN = (const bf16_t*)(ws + OFF_MEMN);
    for (int it = bid; it < 24 + 1536; it += nb) {
        if (it < 8) { cumsum_head((float*)(ws + OFF_F) + (size_t)it * SEQ, lds); continue; }
        f32x4 acc[4][4]; ZERO_ACC(acc);
        if (it < 16) {
            const int j = it - 8, mt = j >> 2, nt = j & 3;
            gemm_acc(MN + (size_t)mt * 128 * DM, DM, WM + (size_t)nt * 128 * DM, DM, DM, lds, acc);
            bf16_t* O = (bf16_t*)(ws + OFF_MK);
            FOR_ACC(acc, { *(u32x2*)(O + (size_t)(mt * 128 + m) * 512 + nt * 128 + n) = pack4(v); });
        } else if (it < 24) {
            const int j = it - 16, mt = j >> 1, nt = j & 1;
            gemm_acc(WM + (size_t)(512 + mt * 128) * DM, DM, MN + (size_t)nt * 128 * DM, DM, DM, lds, acc);
            bf16_t* O = (bf16_t*)(ws + OFF_MVT);
            FOR_ACC(acc, { *(u32x2*)(O + (size_t)(mt * 128 + m) * 256 + nt * 128 + n) = pack4(v); });
        } else {
            const int j = it - 24, mt = j / 12, nt = j % 12;
            gemm_acc(H + (size_t)mt * 128 * DM, DM, WIN + (size_t)nt * 128 * DM, DM, DM, lds, acc);
            bf16_t* O = (bf16_t*)(ws + OFF_BRAW);
            FOR_ACC(acc, { *(u32x2*)(O + (size_t)(mt * 128 + m) * 1536 + nt * 128 + n) = pack4(v); });
        }
    }
}

__device__ __forceinline__ void conv_col(const bf16_t* __restrict__ braw, int t0, int ch, const float* __restrict__ cw, float (&x)[64]) {
    const float w0 = cw[ch], w1 = cw[1536 + ch], w2 = cw[3072 + ch], w3 = cw[4608 + ch];
    float r0 = 0.f, r1 = 0.f, r2 = 0.f;
    if (t0 > 0) { r0 = bf2f(braw[(size_t)(t0 - 3) * 1536 + ch]); r1 = bf2f(braw[(size_t)(t0 - 2) * 1536 + ch]); r2 = bf2f(braw[(size_t)(t0 - 1) * 1536 + ch]); }
#pragma unroll
    for (int c = 0; c < 64; ++c) {
        const float r3 = bf2f(braw[(size_t)(t0 + c) * 1536 + ch]);
        const float v = w0 * r0 + w1 * r1 + w2 * r2 + w3 * r3;
        x[c] = siluf_(v);
        r0 = r1; r1 = r2; r2 = r3;
    }
}

__device__ __forceinline__ void gdn_chunk(const Params& p, int layer, int hd, int n, unsigned char* lds) {
    const int tid = ltid(), lane = tid & 63, wid = tid >> 6, col = tid & 127, half = tid >> 7;
    unsigned char* ws = p.ws;
    const bf16_t* braw = (const bf16_t*)(ws + OFF_BRAW);
    const float* cw = p.conv_w + (size_t)layer * 4 * 1536;
    const int t0 = n * 64;
    unsigned char* item = ws + OFF_GDN + (size_t)(hd * 256 + n) * GDN_ITEM;
    bf16_t* Wg = (bf16_t*)item; bf16_t* QD = (bf16_t*)(item + 16384); bf16_t* KDT = (bf16_t*)(item + 32768); bf16_t* UT = (bf16_t*)(item + 49152); bf16_t* AQK = (bf16_t*)(item + 65536);
    float* SQ = (float*)lds;
    float* PART = (float*)(lds + 66560);
    float* INV = PART + 256;
    float* Gs = INV + 128;
    float* Bs = Gs + 64;
    bf16_t* QB = (bf16_t*)lds;
    bf16_t* KB = QB + 64 * 136;
    float* AM = (float*)(lds + 34816);

    float x[64];
    conv_col(braw, t0, (half ? 512 : 0) + hd * 128 + col, cw, x);
#pragma unroll
    for (int c = 0; c < 64; ++c) SQ[(wid * 64 + c) * 65 + lane] = x[c] * x[c];
    if (tid < 64) {
        float g = ((const float*)(ws + OFF_GLOG))[(size_t)hd * SEQ + t0 + tid];
#pragma unroll
        for (int o = 1; o < 64; o <<= 1) { const float t = __shfl_up(g, o); if (lane >= o) g += t; }
        Gs[tid] = g; Bs[tid] = ((const float*)(ws + OFF_BETA))[(size_t)hd * SEQ + t0 + tid];
    }
    __syncthreads();
    { float s = 0.f;
#pragma unroll 8
      for (int j = 0; j < 64; ++j) s += SQ[(wid * 64 + lane) * 65 + j];
      PART[wid * 64 + lane] = s; }
    __syncthreads();
    if (tid < 64) INV[tid] = rsqrtf(PART[tid] + PART[64 + tid] + EPSV) * 0.08838834764831845f;
    else if (tid < 128) INV[tid] = rsqrtf(PART[128 + tid - 64] + PART[192 + tid - 64] + EPSV);
    __syncthreads();
    const float glast = Gs[63];
#pragma unroll
    for (int c = 0; c < 64; ++c) { x[c] *= INV[half * 64 + c]; (half ? KB : QB)[c * 136 + col] = f2bf(x[c]); }
    if (half == 0) {
#pragma unroll
        for (int c = 0; c < 64; ++c) QD[c * 128 + col] = f2bf(x[c] * __expf(Gs[c]));
        conv_col(braw, t0, 1024 + hd * 128 + col, cw, x);
#pragma unroll
        for (int c = 0; c < 64; ++c) x[c] *= Bs[c];
    } else {
#pragma unroll
        for (int c8 = 0; c8 < 8; ++c8) { u32x4 o;
#pragma unroll
            for (int q = 0; q < 4; ++q) { const int c = c8 * 8 + 2 * q; o[q] = pack2(x[c] * __expf(glast - Gs[c]), x[c + 1] * __expf(glast - Gs[c + 1])); }
            *(u32x4*)(KDT + col * 64 + c8 * 8) = o; }
#pragma unroll
        for (int c = 0; c < 64; ++c) x[c] *= Bs[c] * __expf(Gs[c]);
    }
    if (tid == 0) ((float*)(ws + OFF_EXPGL))[hd * 256 + n] = __expf(glast);
    __syncthreads();
    {
        const int lr = lane & 15, lg = lane >> 4;
        f32x4 kk[4], qk[4];
#pragma unroll
        for (int j = 0; j < 4; ++j) { kk[j] = (f32x4){0.f, 0.f, 0.f, 0.f}; qk[j] = (f32x4){0.f, 0.f, 0.f, 0.f}; }
#pragma unroll
        for (int s = 0; s < 4; ++s) {
            const bf16x8 ka = *(const bf16x8*)(KB + (wid * 16 + lr) * 136 + s * 32 + lg * 8);
            const bf16x8 qa = *(const bf16x8*)(QB + (wid * 16 + lr) * 136 + s * 32 + lg * 8);
#pragma unroll
            for (int j = 0; j < 4; ++j) { const bf16x8 kb = *(const bf16x8*)(KB + (j * 16 + lr) * 136 + s * 32 + lg * 8);
                kk[j] = mfma16(ka, kb, kk[j]); qk[j] = mfma16(qa, kb, qk[j]); }
        }
#pragma unroll
        for (int j = 0; j < 4; ++j)
#pragma unroll
            for (int r = 0; r < 4; ++r) {
                const int c = wid * 16 + 4 * lg + r, s = j * 16 + lr;
                const float e = __expf(s <= c ? Gs[c] - Gs[s] : 0.f);
                AM[c * 68 + s] = (s < c) ? Bs[c] * kk[j][r] * e : 0.f;
                AQK[c * 64 + s] = f2bf((s <= c) ? qk[j][r] * e : 0.f);
            }
    }
    __syncthreads();
#pragma unroll
    for (int c = 1; c < 64; ++c) {
        if ((c & 3) == 0) asm volatile("" ::: "memory");
        float a = x[c];
#pragma unroll
        for (int s4 = 0; s4 < (c + 3) / 4; ++s4) {
            const f32x4 av = *(const f32x4*)(AM + c * 68 + 4 * s4);
#pragma unroll
            for (int q = 0; q < 4; ++q) if (4 * s4 + q < c) a -= av[q] * x[4 * s4 + q];
        }
        x[c] = a;
    }
    if (half == 0) {
#pragma unroll
        for (int c8 = 0; c8 < 8; ++c8) { u32x4 o;
#pragma unroll
            for (int q = 0; q < 4; ++q) o[q] = pack2(x[c8 * 8 + 2 * q], x[c8 * 8 + 2 * q + 1]);
            *(u32x4*)(UT + col * 64 + c8 * 8) = o; }
    } else {
#pragma unroll
        for (int c = 0; c < 64; ++c) Wg[c * 128 + col] = f2bf(x[c]);
    }
    __syncthreads();
}

__device__ __forceinline__ void phase_b2(const Params& p, unsigned char* lds) {
    unsigned char* ws = p.ws; const int bid = lbid(), nb = gridDim.x;
    const bf16_t* H = (const bf16_t*)(ws + OFF_H); const bf16_t* WIN = (const bf16_t*)(ws + OFF_WIN);
    for (int it = bid; it < 128 * 28; it += nb) {
        const int mt = it / 28, nt = it % 28;
        f32x4 acc[4][4]; ZERO_ACC(acc);
        const bf16_t* Wt = WIN + (size_t)(1536 + nt * 128) * DM;
        const bf16_t* Ht = H + (size_t)mt * 128 * DM;
        if (nt >= 8 && nt < 12) {
            gemm_acc(Wt, DM, Ht, DM, DM, lds, acc);
            bf16_t* O = (bf16_t*)(ws + OFF_AVT);
            FOR_ACC(acc, { *(u32x2*)(O + (size_t)((nt - 8) * 128 + m) * SEQ + mt * 128 + n) = pack4(v); });
        } else {
            gemm_acc(Ht, DM, Wt, DM, DM, lds, acc);
            if (nt < 8) { bf16_t* O = (bf16_t*)(ws + (nt < 4 ? OFF_AQ : OFF_AK)); const int c0 = (nt & 3) * 128;
                FOR_ACC(acc, { *(u32x2*)(O + (size_t)(mt * 128 + m) * 512 + c0 + n) = pack4(v); }); }
            else if (nt < 16) { bf16_t* O = (bf16_t*)(ws + OFF_MQ); const int c0 = (nt - 12) * 128;
                FOR_ACC(acc, { *(u32x2*)(O + (size_t)(mt * 128 + m) * 512 + c0 + n) = pack4(v); }); }
            else { const int br = (nt - 16) >> 2, c0 = ((nt - 16) & 3) * 128; bf16_t* O = (bf16_t*)(ws + OFF_SZ) + (size_t)br * SEQ * 512;
                FOR_ACC(acc, { f32x4 s; s[0] = siluf_(v[0]); s[1] = siluf_(v[1]); s[2] = siluf_(v[2]); s[3] = siluf_(v[3]);
                               *(u32x2*)(O + (size_t)(mt * 128 + m) * 512 + c0 + n) = pack4(s); }); }
        }
    }
}

template <int D, bool FOX> __attribute__((always_inline))
__device__ __forceinline__ void flash_item(const bf16_t* __restrict__ Q, int ldq, const bf16_t* __restrict__ Kp, int ldk, const bf16_t* __restrict__ VT, int ldvt,
                           const float* __restrict__ F, int q0, int nkt, float scale, bf16_t* __restrict__ Y, int ldy, unsigned char* lds) {
    constexpr int KS = D / 16, DT = D / 32, KSTR = D + 8, VSTR = 72, KCPR = D / 8;
    constexpr int KCH = 64 * KCPR / 256, VCH = D * 8 / 256;
    bf16_t* Ks = (bf16_t*)lds; bf16_t* VTs = Ks + 64 * KSTR; float* Fk = (float*)(VTs + D * VSTR);
    const int tid = ltid(), lane = tid & 63, wid = tid >> 6, r = lane & 31, h = lane >> 5;
    const int qrow = q0 + wid * 32 + r;
    bf16x8 qf[KS];
#pragma unroll
    for (int s = 0; s < KS; ++s) qf[s] = *(const bf16x8*)(Q + (size_t)qrow * ldq + 16 * s + 8 * h);
    const float Fq = FOX ? F[qrow] : 0.f;
    f32x16 o[DT];
#pragma unroll
    for (int d = 0; d < DT; ++d)
#pragma unroll
        for (int i = 0; i < 16; ++i) o[d][i] = 0.f;
    float mrun = -INFINITY, lrun = 0.f;
    u32x4 rk[KCH], rv[VCH]; float rf = 0.f;
#pragma unroll
    for (int i = 0; i < KCH; ++i) { const int c = tid + 256 * i, row = c / KCPR, ch = c % KCPR; rk[i] = *(const u32x4*)(Kp + (size_t)row * ldk + ch * 8); }
#pragma unroll
    for (int i = 0; i < VCH; ++i) { const int c = tid + 256 * i, row = c >> 3, ch = c & 7; rv[i] = *(const u32x4*)(VT + (size_t)row * ldvt + ch * 8); }
    if (FOX && tid < 64) rf = F[tid];
    for (int kt = 0; kt < nkt; ++kt) {
        if (kt) __syncthreads();
#pragma unroll
        for (int i = 0; i < KCH; ++i) { const int c = tid + 256 * i, row = c / KCPR, ch = c % KCPR; *(u32x4*)(Ks + row * KSTR + ch * 8) = rk[i]; }
#pragma unroll
        for (int i = 0; i < VCH; ++i) { const int c = tid + 256 * i, row = c >> 3, ch = c & 7; *(u32x4*)(VTs + row * VSTR + ch * 8) = rv[i]; }
        if (FOX && tid < 64) Fk[tid] = rf;
        __syncthreads();
        if (kt + 1 < nkt) {
            const int key0 = (kt + 1) * 64;
#pragma unroll
            for (int i = 0; i < KCH; ++i) { const int c = tid + 256 * i, row = c / KCPR, ch = c % KCPR; rk[i] = *(const u32x4*)(Kp + (size_t)(key0 + row) * ldk + ch * 8); }
#pragma unroll
            for (int i = 0; i < VCH; ++i) { const int c = tid + 256 * i, row = c >> 3, ch = c & 7; rv[i] = *(const u32x4*)(VT + (size_t)row * ldvt + key0 + ch * 8); }
            if (FOX && tid < 64) rf = F[key0 + tid];
        }
#pragma unroll
        for (int sub = 0; sub < 2; ++sub) {
            f32x16 st;
#pragma unroll
            for (int i = 0; i < 16; ++i) st[i] = 0.f;
#pragma unroll
            for (int s = 0; s < KS; ++s) { const bf16x8 kf = *(const bf16x8*)(Ks + (sub * 32 + r) * KSTR + 16 * s + 8 * h); st = mfma32(kf, qf[s], st); }
            const int kbase = kt * 64 + sub * 32;
            float mx = -INFINITY;
#pragma unroll
            for (int i = 0; i < 16; ++i) {
                const int krow = (i & 3) + 8 * (i >> 2) + 4 * h;
                float v = st[i] * scale;
                if (FOX) { v += Fq - Fk[sub * 32 + krow]; if (kbase + krow > qrow) v = -INFINITY; }
                st[i] = v; mx = fmaxf(mx, v);
            }
            mx = fmaxf(mx, __shfl_xor(mx, 32));
            const float mnew = fmaxf(mrun, mx);
            const float alpha = __expf(mrun - mnew);
            float ps = 0.f;
#pragma unroll
            for (int i = 0; i < 16; ++i) { const float pv = __expf(st[i] - mnew); st[i] = pv; ps += pv; }
            lrun = lrun * alpha + ps; mrun = mnew;
#pragma unroll
            for (int d = 0; d < DT; ++d) o[d] = o[d] * alpha;
            bf16x8 pf[2];
#pragma unroll
            for (int s2 = 0; s2 < 2; ++s2) { u32x4 u; u.x = pack2(st[8 * s2 + 0], st[8 * s2 + 1]); u.y = pack2(st[8 * s2 + 2], st[8 * s2 + 3]); u.z = pack2(st[8 * s2 + 4], st[8 * s2 + 5]); u.w = pack2(st[8 * s2 + 6], st[8 * s2 + 7]);
                pf[s2] = __builtin_bit_cast(bf16x8, u); }
#pragma unroll
            for (int d = 0; d < DT; ++d)
#pragma unroll
                for (int s2 = 0; s2 < 2; ++s2) {
                    const bf16_t* vp = VTs + (d * 32 + r) * VSTR + sub * 32 + 16 * s2 + 4 * h;
                    const u32x2 lo = *(const u32x2*)vp, hi = *(const u32x2*)(vp + 8);
                    u32x4 u; u.x = lo.x; u.y = lo.y; u.z = hi.x; u.w = hi.y;
                    o[d] = mfma32(__builtin_bit_cast(bf16x8, u), pf[s2], o[d]);
                }
        }
    }
    const float ltot = lrun + __shfl_xor(lrun, 32);
    const float inv = 1.0f / ltot;
#pragma unroll
    for (int d = 0; d < DT; ++d)
#pragma unroll
        for (int g4 = 0; g4 < 4; ++g4) {
            bf16_t* yp = Y + (size_t)qrow * ldy + d * 32 + 8 * g4 + 4 * h;
            const u32x2 zz = *(const u32x2*)yp;
            u32x2 w; w.x = pack2(o[d][4 * g4 + 0] * inv * lo16(zz.x), o[d][4 * g4 + 1] * inv * hi16(zz.x));
            w.y = pack2(o[d][4 * g4 + 2] * inv * lo16(zz.y), o[d][4 * g4 + 3] * inv * hi16(zz.y));
            *(u32x2*)yp = w;
        }
    __syncthreads();
}

__device__ __forceinline__ void gdn_scan(const Params& p, int hd, int es, unsigned char* lds) {
    unsigned char* ws = p.ws;
    bf16_t* ST = (bf16_t*)lds;
    bf16_t* VN = ST + 32 * 136;
    const int tid = ltid(), lane = tid & 63, w = tid >> 6, lr = lane & 15, lg = lane >> 4;
    const int e0 = es * 32;
    for (int i = tid; i < 32 * 136 / 2; i += 256) ((unsigned*)ST)[i] = 0u;
    f32x4 Sacc[2][2];
#pragma unroll
    for (int a = 0; a < 2; ++a)
#pragma unroll
        for (int b = 0; b < 2; ++b) Sacc[a][b] = (f32x4){0.f, 0.f, 0.f, 0.f};
    bf16_t* SZB = (bf16_t*)(ws + OFF_SZ) + (size_t)1 * SEQ * 512;
    float* SSQ = (float*)(ws + OFF_SSQ);
    const float* EG = (const float*)(ws + OFF_EXPGL);
    __syncthreads();
    for (int n = 0; n < 256; ++n) {
        const unsigned char* item = ws + OFF_GDN + (size_t)(hd * 256 + n) * GDN_ITEM;
        const bf16_t* Wg = (const bf16_t*)item; const bf16_t* QD = (const bf16_t*)(item + 16384); const bf16_t* KDT = (const bf16_t*)(item + 32768);
        const bf16_t* UT = (const bf16_t*)(item + 49152); const bf16_t* AQK = (const bf16_t*)(item + 65536);
        bf16x8 wf[4], qf[4], af[2], kf[2][2]; u32x2 uu[2];
#pragma unroll
        for (int s = 0; s < 4; ++s) { wf[s] = *(const bf16x8*)(Wg + (16 * w + lr) * 128 + 32 * s + 8 * lg); qf[s] = *(const bf16x8*)(QD + (16 * w + lr) * 128 + 32 * s + 8 * lg); }
#pragma unroll
        for (int s = 0; s < 2; ++s) af[s] = *(const bf16x8*)(AQK + (16 * w + lr) * 64 + 32 * s + 8 * lg);
#pragma unroll
        for (int dt = 0; dt < 2; ++dt)
#pragma unroll
            for (int s = 0; s < 2; ++s) kf[dt][s] = *(const bf16x8*)(KDT + (32 * w + 16 * dt + lr) * 64 + 32 * s + 8 * lg);
#pragma unroll
        for (int et = 0; et < 2; ++et) uu[et] = *(const u32x2*)(UT + (e0 + 16 * et + lr) * 64 + 16 * w + 4 * lg);
        const float egl = EG[hd * 256 + n];
        f32x4 p1[2], p2[2];
#pragma unroll
        for (int et = 0; et < 2; ++et) { p1[et] = (f32x4){0.f, 0.f, 0.f, 0.f}; p2[et] = (f32x4){0.f, 0.f, 0.f, 0.f}; }
#pragma unroll
        for (int s = 0; s < 4; ++s)
#pragma unroll
            for (int et = 0; et < 2; ++et) { const bf16x8 sb = *(const bf16x8*)(ST + (16 * et + lr) * 136 + 32 * s + 8 * lg);
                p1[et] = mfma16(wf[s], sb, p1[et]); p2[et] = mfma16(qf[s], sb, p2[et]); }
#pragma unroll
        for (int et = 0; et < 2; ++et) {
            f32x4 v; v[0] = lo16(uu[et].x) - p1[et][0]; v[1] = hi16(uu[et].x) - p1[et][1]; v[2] = lo16(uu[et].y) - p1[et][2]; v[3] = hi16(uu[et].y) - p1[et][3];
            *(u32x2*)(VN + (16 * et + lr) * 72 + 16 * w + 4 * lg) = pack4(v);
        }
        __syncthreads();
#pragma unroll
        for (int a = 0; a < 2; ++a)
#pragma unroll
            for (int b = 0; b < 2; ++b) Sacc[a][b] = Sacc[a][b] * egl;
#pragma unroll
        for (int s = 0; s < 2; ++s)
#pragma unroll
            for (int et = 0; et < 2; ++et) { const bf16x8 vb = *(const bf16x8*)(VN + (16 * et + lr) * 72 + 32 * s + 8 * lg);
                p2[et] = mfma16(af[s], vb, p2[et]);
                Sacc[0][et] = mfma16(kf[0][s], vb, Sacc[0][et]); Sacc[1][et] = mfma16(kf[1][s], vb, Sacc[1][et]); }
        {
            float rs[4] = {0.f, 0.f, 0.f, 0.f};
#pragma unroll
            for (int et = 0; et < 2; ++et)
#pragma unroll
                for (int rr = 0; rr < 4; ++rr) {
                    const float ov = p2[et][rr]; rs[rr] += ov * ov;
                    bf16_t* yp = SZB + (size_t)(n * 64 + 16 * w + 4 * lg + rr) * 512 + hd * 128 + e0 + 16 * et + lr;
                    *yp = f2bf(ov * bf2f(*yp));
                }
#pragma unroll
            for (int rr = 0; rr < 4; ++rr) {
                float v = rs[rr];
                v += __shfl_xor(v, 1); v += __shfl_xor(v, 2); v += __shfl_xor(v, 4); v += __shfl_xor(v, 8);
                if (lr == 0) atomicAdd(SSQ + (size_t)(n * 64 + 16 * w + 4 * lg + rr) * 4 + hd, v);
            }
        }
#pragma unroll
        for (int dt = 0; dt < 2; ++dt)
#pragma unroll
            for (int et = 0; et < 2; ++et) *(u32x2*)(ST + (16 * et + lr) * 136 + 32 * w + 16 * dt + 4 * lg) = pack4(Sacc[dt][et]);
        __syncthreads();
    }
}

__device__ __forceinline__ void phase_c(const Params& p, unsigned char* lds) {
    unsigned char* ws = p.ws; const int bid = lbid();
    if (bid < 16) gdn_scan(p, bid >> 2, bid & 3, lds);
    unsigned* ctr = (unsigned*)(ws + OFF_CTR);
    __shared__ unsigned s_item;
    for (;;) {
        __syncthreads();
        if (ltid() == 0) s_item = atomicAdd(ctr, 1u);
        __syncthreads();
        const unsigned it = s_item;
        if (it >= 1024u + 512u) break;
        if (it < 1024u) {
            const int qb = 127 - (int)(it >> 3), hd = it & 7;
            flash_item<64, true>((const bf16_t*)(ws + OFF_AQ) + hd * 64, 512, (const bf16_t*)(ws + OFF_AK) + hd * 64, 512,
                                 (const bf16_t*)(ws + OFF_AVT) + (size_t)hd * 64 * SEQ, SEQ, (const float*)(ws + OFF_F) + (size_t)hd * SEQ,
                                 qb * 128, 2 * qb + 2, 0.125f, (bf16_t*)(ws + OFF_SZ) + hd * 64, 512, lds);
        } else {
            const int j = it - 1024, qb = j >> 2, mh = j & 3;
            flash_item<128, false>((const bf16_t*)(ws + OFF_MQ) + mh * 128, 512, (const bf16_t*)(ws + OFF_MK) + mh * 128, 512,
                                   (const bf16_t*)(ws + OFF_MVT) + (size_t)mh * 128 * 256, 256, nullptr,
                                   qb * 128, 4, 0.08838834764831845f, (bf16_t*)(ws + OFF_SZ) + (size_t)2 * SEQ * 512 + mh * 128, 512, lds);
        }
    }
}

__device__ __forceinline__ void phase_e(const Params& p, int layer) {
    unsigned char* ws = p.ws;
    bf16_t* SZB = (bf16_t*)(ws + OFF_SZ) + (size_t)SEQ * 512;
    const float* SSQ = (const float*)(ws + OFF_SSQ);
    const float* gg = p.gdn_norm_g + layer * 128;
    const int total = SEQ * 512 / 8;
    for (int i = lbid() * 256 + ltid(); i < total; i += gridDim.x * 256) {
        const int row = i >> 6, c8 = (i & 63) * 8, hd = c8 >> 7, e = c8 & 127;
        const float rstd = rsqrtf(SSQ[row * 4 + hd] * (1.0f / 128.0f) + EPSV);
        u32x4 u = *(const u32x4*)(SZB + (size_t)row * 512 + c8);
#pragma unroll
        for (int q = 0; q < 4; ++q) u[q] = pack2(lo16(u[q]) * rstd * gg[e + 2 * q], hi16(u[q]) * rstd * gg[e + 2 * q + 1]);
        *(u32x4*)(SZB + (size_t)row * 512 + c8) = u;
    }
}

__device__ __forceinline__ void phase_d1(const Params& p, int layer, unsigned char* lds) {
    unsigned char* ws = p.ws; const int bid = lbid(), nb = gridDim.x;
    const bf16_t* H = (const bf16_t*)(ws + OFF_H); const bf16_t* WIN = (const bf16_t*)(ws + OFF_WIN); const bf16_t* WBR = (const bf16_t*)(ws + OFF_WBR);
    const bf16_t* Yb = (const bf16_t*)(ws + OFF_SZ);
    const float* bm = p.b_merge + layer * 3072;
    bf16_t* MG = (bf16_t*)(ws + OFF_MERGED);
    for (int it = bid; it < 1024; it += nb) {
        const int mt = it >> 3, nt = it & 7;
        f32x4 mg[4][4]; ZERO_ACC(mg);
#pragma unroll 1
        for (int br = 0; br < 3; ++br) {
            f32x4 acc[4][4]; ZERO_ACC(acc);
            gemm_acc(H + (size_t)mt * 128 * DM, DM, WIN + (size_t)(5120 + br * 1024 + nt * 128) * DM, DM, DM, lds, acc);
            unsigned* GP = (unsigned*)(lds + 36864) + ltid();
            {
                const int lane_ = ltid() & 63, wid_ = ltid() >> 6, wc_ = wid_ & 1;
#pragma unroll
                for (int i_ = 0; i_ < 4; ++i_)
#pragma unroll
                    for (int j_ = 0; j_ < 4; ++j_) {
                        const int n = wc_ * 64 + j_ * 16 + 4 * (lane_ >> 4);
                        const f32x4 bv = *(const f32x4*)(bm + br * 1024 + nt * 128 + n);
                        const f32x4 v = acc[i_][j_];
                        GP[((i_ * 4 + j_) * 2 + 0) * 256] = pack2(sigmoidf_(v[0] + bv[0]), sigmoidf_(v[1] + bv[1]));
                        GP[((i_ * 4 + j_) * 2 + 1) * 256] = pack2(sigmoidf_(v[2] + bv[2]), sigmoidf_(v[3] + bv[3]));
                    }
            }
            ZERO_ACC(acc);
            gemm_acc(Yb + (size_t)br * SEQ * 512 + (size_t)mt * 128 * 512, 512, WBR + (size_t)br * 1024 * 512 + (size_t)nt * 128 * 512, 512, 512, lds, acc);
#pragma unroll
            for (int i_ = 0; i_ < 4; ++i_)
#pragma unroll
                for (int j_ = 0; j_ < 4; ++j_) {
                    const unsigned g0 = GP[((i_ * 4 + j_) * 2 + 0) * 256], g1 = GP[((i_ * 4 + j_) * 2 + 1) * 256];
                    mg[i_][j_][0] += lo16(g0) * acc[i_][j_][0]; mg[i_][j_][1] += hi16(g0) * acc[i_][j_][1];
                    mg[i_][j_][2] += lo16(g1) * acc[i_][j_][2]; mg[i_][j_][3] += hi16(g1) * acc[i_][j_][3];
                }
        }
        FOR_ACC(mg, { *(u32x2*)(MG + (size_t)(mt * 128 + m) * DM + nt * 128 + n) = pack4(v); });
    }
}

__device__ __forceinline__ void phase_d2(const Params& p, int layer, unsigned char* lds) {
    unsigned char* ws = p.ws; const int bid = lbid(), nb = gridDim.x;
    const bf16_t* MG = (const bf16_t*)(ws + OFF_MERGED); const bf16_t* WO = (const bf16_t*)(ws + OFF_WOUT);
    const float* xin = layer == 0 ? p.x : p.out;
    for (int it = bid; it < 1024; it += nb) {
        const int mt = it >> 3, nt = it & 7;
        f32x4 acc[4][4]; ZERO_ACC(acc);
        gemm_acc(MG + (size_t)mt * 128 * DM, DM, WO + (size_t)nt * 128 * DM, DM, DM, lds, acc);
        FOR_ACC(acc, { const size_t off = (size_t)(mt * 128 + m) * DM + nt * 128 + n; const f32x4 xv = *(const f32x4*)(xin + off); *(f32x4*)(p.out + off) = xv + v; });
    }
}

__device__ __forceinline__ void phase_final(const Params& p) {
    const int tid = ltid(), lane = tid & 63, wid = tid >> 6;
    f32x4 g[4];
#pragma unroll
    for (int i = 0; i < 4; ++i) g[i] = *(const f32x4*)(p.final_norm_g + 4 * lane + 256 * i);
    for (int row = lbid() * 4 + wid; row < SEQ; row += gridDim.x * 4) {
        f32x4 xv[4]; float ss = 0.f;
#pragma unroll
        for (int i = 0; i < 4; ++i) { xv[i] = *(const f32x4*)(p.out + (size_t)row * DM + 4 * lane + 256 * i); ss += xv[i][0] * xv[i][0] + xv[i][1] * xv[i][1] + xv[i][2] * xv[i][2] + xv[i][3] * xv[i][3]; }
        ss = wave_sum(ss);
        const float rstd = rsqrtf(ss * (1.0f / DM) + EPSV);
#pragma unroll
        for (int i = 0; i < 4; ++i) *(f32x4*)(p.out + (size_t)row * DM + 4 * lane + 256 * i) = xv[i] * rstd * g[i];
    }
}

__global__ void __launch_bounds__(256, 1) fwd_megakernel(Params p) {
    __shared__ __attribute__((aligned(16))) unsigned char lds[LDS_BYTES];
    cg::grid_group grid = cg::this_grid();
    for (int layer = 0; layer < 2; ++layer) {
        phase_a(p, layer, lds);
        grid.sync();
        phase_b1(p, lds);
        grid.sync();
        for (int it = lbid(); it < 1024; it += gridDim.x) gdn_chunk(p, layer, it >> 8, it & 255, lds);
        grid.sync();
        phase_b2(p, lds);
        grid.sync();
        phase_c(p, lds);
        grid.sync();
        phase_e(p, layer);
        grid.sync();
        phase_d1(p, layer, lds);
        grid.sync();
        phase_d2(p, layer, lds);
        grid.sync();
    }
    phase_final(p);
}

extern "C" void kernel_launch(void* const* d_in, const int* in_sizes, int n_in, void* d_out, int out_size, void* d_ws, size_t ws_size, hipStream_t stream) {
    static int grid_blocks = 0;
    if (!grid_blocks) {
        int dev = 0, cus = 0, per_cu = 0;
        hipGetDevice(&dev);
        hipDeviceGetAttribute(&cus, hipDeviceAttributeMultiprocessorCount, dev);
        hipOccupancyMaxActiveBlocksPerMultiprocessor(&per_cu, fwd_megakernel, 256, 0);
        if (per_cu > 2) per_cu = 2;
        if (per_cu < 1) per_cu = 1;
        grid_blocks = cus * per_cu;
    }
    Params p{};
    p.x = (const float*)d_in[0]; p.mem = (const float*)d_in[1]; p.norm_g = (const float*)d_in[2]; p.w_in = (const float*)d_in[3];
    p.b_fg = (const float*)d_in[4]; p.b_merge = (const float*)d_in[5]; p.conv_w = (const float*)d_in[6]; p.a_log = (const float*)d_in[7];
    p.dt_bias = (const float*)d_in[8]; p.gdn_norm_g = (const float*)d_in[9]; p.mem_norm_g = (const float*)d_in[10]; p.w_mem_kv = (const float*)d_in[11];
    p.w_branch = (const float*)d_in[12]; p.w_out = (const float*)d_in[13]; p.final_norm_g = (const float*)d_in[14];
    p.out = (float*)d_out; p.ws = (unsigned char*)d_ws;
    void* args[] = {&p};
    hipError_t e = hipLaunchCooperativeKernel((void*)fwd_megakernel, dim3(grid_blocks), dim3(256), args, 0, stream);
    if (e != hipSuccess) fprintf(stderr, "cooperative launch failed: %s (grid %d)\n", hipGetErrorString(e), grid_blocks);
}
```

```cpp
#include <hip/hip_runtime.h>
#include <hip/hip_cooperative_groups.h>
#include <cstdio>
#include <cstdint>
namespace cg = cooperative_groups;

typedef unsigned short bf16_t;
typedef short bf16x8 __attribute__((ext_vector_type(8)));
typedef float f32x4 __attribute__((ext_vector_type(4)));
typedef float f32x16 __attribute__((ext_vector_type(16)));
typedef unsigned u32x4 __attribute__((ext_vector_type(4)));
typedef unsigned u32x2 __attribute__((ext_vector_type(2)));

#define SEQ 16384
#define DM 1024
#define NIN 8208
#define EPSV 1e-6f

#define OFF_WIN   0ull
#define OFF_WBR   16777216ull
#define OFF_WOUT  19922944ull
#define OFF_WMEM  22020096ull
#define OFF_H     24117248ull
#define OFF_BRAW  57671680ull
#define OFF_AQ    (OFF_BRAW)
#define OFF_AK    (OFF_BRAW + 16777216ull)
#define OFF_AVT   (OFF_BRAW + 33554432ull)
#define OFF_MERGED (OFF_BRAW)
#define OFF_GDN   108003328ull
#define OFF_MQ    183500800ull
#define OFF_SZ    200278016ull
#define OFF_F     250609664ull
#define OFF_GLOG  (OFF_F + 524288ull)
#define OFF_BETA  (OFF_GLOG + 262144ull)
#define OFF_SSQ   (OFF_BETA + 262144ull)
#define OFF_MEMN  (OFF_SSQ + 262144ull)
#define OFF_MK    (OFF_MEMN + 524288ull)
#define OFF_MVT   (OFF_MK + 262144ull)
#define OFF_EXPGL (OFF_MVT + 262144ull)
#define OFF_CTR   (OFF_EXPGL + 4096ull)
#define GDN_ITEM 73728

#define LDS_BYTES 69632

struct Params {
    const float* x; const float* mem; const float* norm_g; const float* w_in; const float* b_fg; const float* b_merge;
    const float* conv_w; const float* a_log; const float* dt_bias; const float* gdn_norm_g; const float* mem_norm_g;
    const float* w_mem_kv; const float* w_branch; const float* w_out; const float* final_norm_g;
    float* out; unsigned char* ws;
};

__device__ __forceinline__ int ltid() { int t = __builtin_amdgcn_workitem_id_x(); asm volatile("" : "+v"(t)); return t; }
__device__ __forceinline__ int lbid() { int t = __builtin_amdgcn_workgroup_id_x(); asm volatile("" : "+s"(t)); return t; }
__device__ __forceinline__ unsigned char* lptr(unsigned char* q) { asm volatile("" : "+s"(q)); return q; }
__device__ __forceinline__ float bf2f(bf16_t b) { return __uint_as_float(((unsigned)b) << 16); }
__device__ __forceinline__ bf16_t f2bf(float f) { unsigned u = __float_as_uint(f); u += 0x7fffu + ((u >> 16) & 1u); return (bf16_t)(u >> 16); }
__device__ __forceinline__ unsigned pack2(float lo, float hi) { return (unsigned)f2bf(lo) | ((unsigned)f2bf(hi) << 16); }
__device__ __forceinline__ u32x2 pack4(f32x4 v) { u32x2 r; r.x = pack2(v[0], v[1]); r.y = pack2(v[2], v[3]); return r; }
__device__ __forceinline__ float lo16(unsigned u) { return __uint_as_float(u << 16); }
__device__ __forceinline__ float hi16(unsigned u) { return __uint_as_float(u & 0xffff0000u); }
__device__ __forceinline__ f32x4 mfma16(bf16x8 a, bf16x8 b, f32x4 c) { return __builtin_amdgcn_mfma_f32_16x16x32_bf16(a, b, c, 0, 0, 0); }
__device__ __forceinline__ f32x16 mfma32(bf16x8 a, bf16x8 b, f32x16 c) { return __builtin_amdgcn_mfma_f32_32x32x16_bf16(a, b, c, 0, 0, 0); }
__device__ __forceinline__ float sigmoidf_(float x) { return 1.0f / (1.0f + __expf(-x)); }
__device__ __forceinline__ float siluf_(float x) { return x / (1.0f + __expf(-x)); }
__device__ __forceinline__ float softplusf_(float x) { return fmaxf(x, 0.f) + log1pf(expf(-fabsf(x))); }
__device__ __forceinline__ float wave_sum(float v) {
#pragma unroll
    for (int o = 32; o >= 1; o >>= 1) v += __shfl_xor(v, o);
    return v;
}

__device__ __forceinline__ void gemm_acc(const bf16_t* __restrict__ A, int lda, const bf16_t* __restrict__ B, int ldb, int K,
                                         unsigned char* lds, f32x4 (&acc)[4][4]) {
    bf16_t* As = (bf16_t*)lds; bf16_t* Bs = As + 128 * 72;
    const int tid = ltid(), lane = tid & 63, wid = tid >> 6, wr = wid >> 1, wc = wid & 1, lr = lane & 15, lg = lane >> 4;
    u32x4 ra[4], rb[4];
    const int nk = K >> 6;
#pragma unroll
    for (int i = 0; i < 4; ++i) { const int c = tid + 256 * i, row = c >> 3, ch = c & 7;
        ra[i] = *(const u32x4*)(A + (size_t)row * lda + ch * 8); rb[i] = *(const u32x4*)(B + (size_t)row * ldb + ch * 8); }
    for (int kt = 0; kt < nk; ++kt) {
        if (kt) __syncthreads();
#pragma unroll
        for (int i = 0; i < 4; ++i) { const int c = tid + 256 * i, row = c >> 3, ch = c & 7;
            *(u32x4*)(As + row * 72 + ch * 8) = ra[i]; *(u32x4*)(Bs + row * 72 + ch * 8) = rb[i]; }
        __syncthreads();
        if (kt + 1 < nk) {
            const int k0 = (kt + 1) << 6;
#pragma unroll
            for (int i = 0; i < 4; ++i) { const int c = tid + 256 * i, row = c >> 3, ch = c & 7;
                ra[i] = *(const u32x4*)(A + (size_t)row * lda + k0 + ch * 8); rb[i] = *(const u32x4*)(B + (size_t)row * ldb + k0 + ch * 8); }
        }
#pragma unroll
        for (int s = 0; s < 2; ++s) {
            bf16x8 bfr[4];
#pragma unroll
            for (int j = 0; j < 4; ++j) bfr[j] = *(const bf16x8*)(Bs + (wc * 64 + j * 16 + lr) * 72 + s * 32 + lg * 8);
#pragma unroll
            for (int i = 0; i < 4; ++i) {
                const bf16x8 af = *(const bf16x8*)(As + (wr * 64 + i * 16 + lr) * 72 + s * 32 + lg * 8);
#pragma unroll
                for (int j = 0; j < 4; ++j) acc[i][j] = mfma16(bfr[j], af, acc[i][j]);
            }
        }
    }
    __syncthreads();
}
#define ZERO_ACC(acc) _Pragma("unroll") for (int i_ = 0; i_ < 4; ++i_) _Pragma("unroll") for (int j_ = 0; j_ < 4; ++j_) acc[i_][j_] = (f32x4){0.f, 0.f, 0.f, 0.f}
#define FOR_ACC(acc, BODY) do { const int lane_ = ltid() & 63, wid_ = ltid() >> 6, wr_ = wid_ >> 1, wc_ = wid_ & 1; \
    _Pragma("unroll") for (int i_ = 0; i_ < 4; ++i_) _Pragma("unroll") for (int j_ = 0; j_ < 4; ++j_) { \
        const int m = wr_ * 64 + i_ * 16 + (lane_ & 15), n = wc_ * 64 + j_ * 16 + 4 * (lane_ >> 4); f32x4& v = acc[i_][j_]; BODY } } while (0)

__device__ __forceinline__ void transpose_tile(const float* __restrict__ src, int ldsrc, int k0, int c0, bf16_t* __restrict__ dst, int lddst, int n0, unsigned char* lds) {
    float* T = (float*)lds;
    const int tid = ltid();
#pragma unroll
    for (int i = 0; i < 16; ++i) { const int k = (tid >> 6) + 4 * i, n = tid & 63; T[k * 65 + n] = src[(size_t)(k0 + k) * ldsrc + c0 + n]; }
    __syncthreads();
#pragma unroll
    for (int i = 0; i < 8; ++i) { const int n = (tid >> 5) + 8 * i, k = 2 * (tid & 31);
        *(unsigned*)(dst + (size_t)(n0 + n) * lddst + k0 + k) = pack2(T[k * 65 + n], T[(k + 1) * 65 + n]); }
    __syncthreads();
}
__device__ __forceinline__ int win_orig_col(int nr) {
    if (nr < 1536) return 2056 + nr;
    if (nr < 3072) return nr - 1536;
    if (nr < 3584) return 4112 + (nr - 3072);
    if (nr < 4096) return 1544 + (nr - 3584);
    if (nr < 4608) return 3600 + (nr - 4096);
    if (nr < 5120) return 4624 + (nr - 4608);
    return 5136 + (nr - 5120);
}

__device__ __forceinline__ void phase_a(const Params& p, int layer, unsigned char* lds) {
    const int tid = ltid(), lane = tid & 63, wid = tid >> 6, bid = lbid(), nb = gridDim.x;
    unsigned char* ws = lptr(p.ws);
    const float* xin = layer == 0 ? p.x : p.out;
    const float* w_in = p.w_in + (size_t)layer * DM * NIN;
    {
        float* ssq = (float*)(ws + OFF_SSQ);
        for (int i = bid * 256 + tid; i < 65536; i += nb * 256) ssq[i] = 0.f;
        if (bid == 0 && tid < 64) ((unsigned*)(ws + OFF_CTR))[tid] = 0u;
    }
    float* Wsm = (float*)lds;
    for (int k = tid; k < 1024; k += 256) {
        const float* r = w_in + (size_t)k * NIN;
        f32x4 a0 = *(const f32x4*)(r + 1536), a1 = *(const f32x4*)(r + 1540), b0 = *(const f32x4*)(r + 3592), b1 = *(const f32x4*)(r + 3596);
#pragma unroll
        for (int q = 0; q < 4; ++q) { Wsm[q * 1024 + k] = a0[q]; Wsm[(4 + q) * 1024 + k] = a1[q]; Wsm[(8 + q) * 1024 + k] = b0[q]; Wsm[(12 + q) * 1024 + k] = b1[q]; }
    }
    __syncthreads();
    {
        const float* ng = p.norm_g + layer * DM;
        f32x4 g[4];
#pragma unroll
        for (int i = 0; i < 4; ++i) g[i] = *(const f32x4*)(ng + 4 * lane + 256 * i);
        bf16_t* H = (bf16_t*)(ws + OFF_H);
        float* Fb = (float*)(ws + OFF_F); float* GL = (float*)(ws + OFF_GLOG); float* BT = (float*)(ws + OFF_BETA);
        for (int row = bid * 4 + wid; row < SEQ; row += nb * 4) {
            asm volatile("" ::: "memory");
            f32x4 xv[4]; float ss = 0.f;
#pragma unroll
            for (int i = 0; i < 4; ++i) { xv[i] = *(const f32x4*)(xin + (size_t)row * DM + 4 * lane + 256 * i); ss += xv[i][0] * xv[i][0] + xv[i][1] * xv[i][1] + xv[i][2] * xv[i][2] + xv[i][3] * xv[i][3]; }
            ss = wave_sum(ss);
            const float rstd = rsqrtf(ss * (1.0f / DM) + EPSV);
#pragma unroll
            for (int i = 0; i < 4; ++i) { xv[i] = xv[i] * rstd * g[i]; *(u32x2*)(H + (size_t)row * DM + 4 * lane + 256 * i) = pack4(xv[i]); }
            float myv = 0.f;
#pragma unroll
            for (int c = 0; c < 16; ++c) {
                float d = 0.f;
#pragma unroll
                for (int i = 0; i < 4; ++i) { const f32x4 w = *(const f32x4*)(Wsm + c * 1024 + 4 * lane + 256 * i); d += xv[i][0] * w[0] + xv[i][1] * w[1] + xv[i][2] * w[2] + xv[i][3] * w[3]; }
                d = wave_sum(d);
                if (lane == c) myv = d;
            }
            if (lane < 8) { const float z = myv + p.b_fg[layer * 8 + lane]; Fb[(size_t)lane * SEQ + row] = -softplusf_(-z); }
            else if (lane < 12) { const int hd = lane - 8; GL[(size_t)hd * SEQ + row] = -expf(p.a_log[layer * 4 + hd]) * softplusf_(myv + p.dt_bias[layer * 4 + hd]); }
            else if (lane < 16) { const int hd = lane - 12; BT[(size_t)hd * SEQ + row] = 1.0f / (1.0f + expf(-myv)); }
        }
        const float* mg = p.mem_norm_g + layer * DM;
        bf16_t* MN = (bf16_t*)(ws + OFF_MEMN);
        for (int row = bid * 4 + wid; row < 256; row += nb * 4) {
            f32x4 xv[4]; float ss = 0.f;
#pragma unroll
            for (int i = 0; i < 4; ++i) { xv[i] = *(const f32x4*)(p.mem + (size_t)row * DM + 4 * lane + 256 * i); ss += xv[i][0] * xv[i][0] + xv[i][1] * xv[i][1] + xv[i][2] * xv[i][2] + xv[i][3] * xv[i][3]; }
            ss = wave_sum(ss);
            const float rstd = rsqrtf(ss * (1.0f / DM) + EPSV);
#pragma unroll
            for (int i = 0; i < 4; ++i) { const f32x4 gg = *(const f32x4*)(mg + 4 * lane + 256 * i); xv[i] = xv[i] * rstd * gg; *(u32x2*)(MN + (size_t)row * DM + 4 * lane + 256 * i) = pack4(xv[i]); }
        }
    }
    __syncthreads();
    for (int it = bid; it < 2944; it += nb) {
        if (it < 2048) { const int nt = it >> 4, kt = it & 15; transpose_tile(w_in, NIN, kt * 64, win_orig_col(nt * 64), (bf16_t*)(ws + OFF_WIN), 1024, nt * 64, lds); }
        else if (it < 2432) { const int j = it - 2048, br = j >> 7, r = j & 127, nt = r >> 3, kt = r & 7;
            transpose_tile(p.w_branch + ((size_t)layer * 3 + br) * 512 * 1024, 1024, kt * 64, nt * 64, (bf16_t*)(ws + OFF_WBR) + (size_t)br * 1024 * 512, 512, nt * 64, lds); }
        else if (it < 2688) { const int j = it - 2432, nt = j >> 4, kt = j & 15; transpose_tile(p.w_out + (size_t)layer * DM * DM, DM, kt * 64, nt * 64, (bf16_t*)(ws + OFF_WOUT), 1024, nt * 64, lds); }
        else { const int j = it - 2688, nt = j >> 4, kt = j & 15; transpose_tile(p.w_mem_kv + (size_t)layer * DM * DM, DM, kt * 64, nt * 64, (bf16_t*)(ws + OFF_WMEM), 1024, nt * 64, lds); }
    }
}

__device__ __forceinline__ void cumsum_head(float* F, unsigned char* lds) {
    double* part = (double*)lds;
    const int tid = ltid();
    double s = 0.0;
    for (int i = 0; i < 64; ++i) s += (double)F[tid * 64 + i];
    part[tid] = s;
    __syncthreads();
    if (tid == 0) { double run = 0.0; for (int i = 0; i < 256; ++i) { const double t = part[i]; part[i] = run; run += t; } }
    __syncthreads();
    double run = part[tid];
    for (int i = 0; i < 64; ++i) { run += (double)F[tid * 64 + i]; F[tid * 64 + i] = (float)run; }
    __syncthreads();
}

__device__ __forceinline__ void phase_b1(const Params& p, unsigned char* lds) {
    unsigned char* ws = lptr(p.ws); const int bid = lbid(), nb = gridDim.x;
    const bf16_t* H = (const bf16_t*)(ws + OFF_H); const bf16_t* WIN = (const bf16_t*)(ws + OFF_WIN);
    const bf16_t* WM = (const bf16_t*)(ws + OFF_WMEM); const bf16_t* MN = (const bf16_t*)(ws + OFF_MEMN);
    for (int it = bid; it < 24 + 1536; it += nb) {
        if (it < 8) { cumsum_head((float*)(ws + OFF_F) + (size_t)it * SEQ, lds); continue; }
        f32x4 acc[4][4]; ZERO_ACC(acc);
        if (it < 16) {
            const int j = it - 8, mt = j >> 2, nt = j & 3;
            gemm_acc(MN + (size_t)mt * 128 * DM, DM, WM + (size_t)nt * 128 * DM, DM, DM, lds, acc);
            bf16_t* O = (bf16_t*)(ws + OFF_MK);
            FOR_ACC(acc, { *(u32x2*)(O + (size_t)(mt * 128 + m) * 512 + nt * 128 + n) = pack4(v); });
        } else if (it < 24) {
            const int j = it - 16, mt = j >> 1, nt = j & 1;
            gemm_acc(WM + (size_t)(512 + mt * 128) * DM, DM, MN + (size_t)nt * 128 * DM, DM, DM, lds, acc);
            bf16_t* O = (bf16_t*)(ws + OFF_MVT);
            FOR_ACC(acc, { *(u32x2*)(O + (size_t)(mt * 128 + m) * 256 + nt * 128 + n) = pack4(v); });
        } else {
            const int j = it - 24, mt = j / 12, nt = j % 12;
            gemm_acc(H + (size_t)mt * 128 * DM, DM, WIN + (size_t)nt * 128 * DM, DM, DM, lds, acc);
            bf16_t* O = (bf16_t*)(ws + OFF_BRAW);
            FOR_ACC(acc, { *(u32x2*)(O + (size_t)(mt * 128 + m) * 1536 + nt * 128 + n) = pack4(v); });
        }
    }
}

__device__ __forceinline__ void conv_col(const bf16_t* __restrict__ braw, int t0, int ch, const float* __restrict__ cw, float (&x)[64]) {
    const float w0 = cw[ch], w1 = cw[1536 + ch], w2 = cw[3072 + ch], w3 = cw[4608 + ch];
    float r0 = 0.f, r1 = 0.f, r2 = 0.f;
    if (t0 > 0) { r0 = bf2f(braw[(size_t)(t0 - 3) * 1536 + ch]); r1 = bf2f(braw[(size_t)(t0 - 2) * 1536 + ch]); r2 = bf2f(braw[(size_t)(t0 - 1) * 1536 + ch]); }
#pragma unroll
    for (int c = 0; c < 64; ++c) {
        if ((c & 15) == 0) asm volatile("" ::: "memory");
        const float r3 = bf2f(braw[(size_t)(t0 + c) * 1536 + ch]);
        const float v = w0 * r0 + w1 * r1 + w2 * r2 + w3 * r3;
        x[c] = siluf_(v);
        r0 = r1; r1 = r2; r2 = r3;
    }
}

__device__ __forceinline__ void gdn_chunk(const Params& p, int layer, int hd, int n, unsigned char* lds) {
    const int tid = ltid(), lane = tid & 63, wid = tid >> 6, col = tid & 127, half = tid >> 7;
    unsigned char* ws = lptr(p.ws);
    const bf16_t* braw = (const bf16_t*)(ws + OFF_BRAW);
    const float* cw = p.conv_w + (size_t)layer * 4 * 1536;
    const int t0 = n * 64;
    unsigned char* item = ws + OFF_GDN + (size_t)(hd * 256 + n) * GDN_ITEM;
    bf16_t* Wg = (bf16_t*)item; bf16_t* QD = (bf16_t*)(item + 16384); bf16_t* KDT = (bf16_t*)(item + 32768); bf16_t* UT = (bf16_t*)(item + 49152); bf16_t* AQK = (bf16_t*)(item + 65536);
    float* SQ = (float*)lds;
    float* PART = (float*)(lds + 66560);
    float* INV = PART + 256;
    float* Gs = INV + 128;
    float* Bs = Gs + 64;
    bf16_t* QB = (bf16_t*)lds;
    bf16_t* KB = QB + 64 * 136;
    float* AM = (float*)(lds + 34816);

    float x[64];
    conv_col(braw, t0, (half ? 512 : 0) + hd * 128 + col, cw, x);
#pragma unroll
    for (int c = 0; c < 64; ++c) SQ[(wid * 64 + c) * 65 + lane] = x[c] * x[c];
    if (tid < 64) {
        float g = ((const float*)(ws + OFF_GLOG))[(size_t)hd * SEQ + t0 + tid];
#pragma unroll
        for (int o = 1; o < 64; o <<= 1) { const float t = __shfl_up(g, o); if (lane >= o) g += t; }
        Gs[tid] = g; Bs[tid] = ((const float*)(ws + OFF_BETA))[(size_t)hd * SEQ + t0 + tid];
    }
    __syncthreads();
    { float s = 0.f;
#pragma unroll 8
      for (int j = 0; j < 64; ++j) s += SQ[(wid * 64 + lane) * 65 + j];
      PART[wid * 64 + lane] = s; }
    __syncthreads();
    if (tid < 64) INV[tid] = rsqrtf(PART[tid] + PART[64 + tid] + EPSV) * 0.08838834764831845f;
    else if (tid < 128) INV[tid] = rsqrtf(PART[128 + tid - 64] + PART[192 + tid - 64] + EPSV);
    __syncthreads();
    const float glast = Gs[63];
#pragma unroll
    for (int c = 0; c < 64; ++c) { if ((c & 15) == 0) asm volatile("" ::: "memory"); x[c] *= INV[half * 64 + c]; (half ? KB : QB)[c * 136 + col] = f2bf(x[c]); }
    if (half == 0) {
#pragma unroll
        for (int c = 0; c < 64; ++c) { if ((c & 15) == 0) asm volatile("" ::: "memory"); QD[c * 128 + col] = f2bf(x[c] * __expf(Gs[c])); }
        conv_col(braw, t0, 1024 + hd * 128 + col, cw, x);
#pragma unroll
        for (int c = 0; c < 64; ++c) x[c] *= Bs[c];
    } else {
#pragma unroll
        for (int c8 = 0; c8 < 8; ++c8) { u32x4 o;
#pragma unroll
            for (int q = 0; q < 4; ++q) { const int c = c8 * 8 + 2 * q; o[q] = pack2(x[c] * __expf(glast - Gs[c]), x[c + 1] * __expf(glast - Gs[c + 1])); }
            *(u32x4*)(KDT + col * 64 + c8 * 8) = o; }
#pragma unroll
        for (int c = 0; c < 64; ++c) { if ((c & 15) == 0) asm volatile("" ::: "memory"); x[c] *= Bs[c] * __expf(Gs[c]); }
    }
    if (tid == 0) ((float*)(ws + OFF_EXPGL))[hd * 256 + n] = __expf(glast);
    __syncthreads();
    {
        const int lr = lane & 15, lg = lane >> 4;
        f32x4 kk[4], qk[4];
#pragma unroll
        for (int j = 0; j < 4; ++j) { kk[j] = (f32x4){0.f, 0.f, 0.f, 0.f}; qk[j] = (f32x4){0.f, 0.f, 0.f, 0.f}; }
#pragma unroll
        for (int s = 0; s < 4; ++s) {
            const bf16x8 ka = *(const bf16x8*)(KB + (wid * 16 + lr) * 136 + s * 32 + lg * 8);
            const bf16x8 qa = *(const bf16x8*)(QB + (wid * 16 + lr) * 136 + s * 32 + lg * 8);
#pragma unroll
            for (int j = 0; j < 4; ++j) { const bf16x8 kb = *(const bf16x8*)(KB + (j * 16 + lr) * 136 + s * 32 + lg * 8);
                kk[j] = mfma16(ka, kb, kk[j]); qk[j] = mfma16(qa, kb, qk[j]); }
        }
#pragma unroll
        for (int j = 0; j < 4; ++j)
#pragma unroll
            for (int r = 0; r < 4; ++r) {
                const int c = wid * 16 + 4 * lg + r, s = j * 16 + lr;
                const float e = __expf(s <= c ? Gs[c] - Gs[s] : 0.f);
                AM[c * 68 + s] = (s < c) ? Bs[c] * kk[j][r] * e : 0.f;
                AQK[c * 64 + s] = f2bf((s <= c) ? qk[j][r] * e : 0.f);
            }
    }
    __syncthreads();
#pragma unroll
    for (int c = 1; c < 64; ++c) {
        if ((c & 1) == 0) asm volatile("" ::: "memory");
        float a = x[c];
#pragma unroll
        for (int s4 = 0; s4 < (c + 3) / 4; ++s4) {
            const f32x4 av = *(const f32x4*)(AM + c * 68 + 4 * s4);
#pragma unroll
            for (int q = 0; q < 4; ++q) if (4 * s4 + q < c) a -= av[q] * x[4 * s4 + q];
        }
        x[c] = a;
    }
    if (half == 0) {
#pragma unroll
        for (int c8 = 0; c8 < 8; ++c8) { u32x4 o;
#pragma unroll
            for (int q = 0; q < 4; ++q) o[q] = pack2(x[c8 * 8 + 2 * q], x[c8 * 8 + 2 * q + 1]);
            *(u32x4*)(UT + col * 64 + c8 * 8) = o; }
    } else {
#pragma unroll
        for (int c = 0; c < 64; ++c) Wg[c * 128 + col] = f2bf(x[c]);
    }
    __syncthreads();
}

__device__ __forceinline__ void phase_b2(const Params& p, unsigned char* lds) {
    unsigned char* ws = lptr(p.ws); const int bid = lbid(), nb = gridDim.x;
    const bf16_t* H = (const bf16_t*)(ws + OFF_H); const bf16_t* WIN = (const bf16_t*)(ws + OFF_WIN);
    for (int it = bid; it < 128 * 28; it += nb) {
        const int mt = it / 28, nt = it % 28;
        f32x4 acc[4][4]; ZERO_ACC(acc);
        const bf16_t* Wt = WIN + (size_t)(1536 + nt * 128) * DM;
        const bf16_t* Ht = H + (size_t)mt * 128 * DM;
        if (nt >= 8 && nt < 12) {
            gemm_acc(Wt, DM, Ht, DM, DM, lds, acc);
            bf16_t* O = (bf16_t*)(ws + OFF_AVT);
            FOR_ACC(acc, { *(u32x2*)(O + (size_t)((nt - 8) * 128 + m) * SEQ + mt * 128 + n) = pack4(v); });
        } else {
            gemm_acc(Ht, DM, Wt, DM, DM, lds, acc);
            if (nt < 8) { bf16_t* O = (bf16_t*)(ws + (nt < 4 ? OFF_AQ : OFF_AK)); const int c0 = (nt & 3) * 128;
                FOR_ACC(acc, { *(u32x2*)(O + (size_t)(mt * 128 + m) * 512 + c0 + n) = pack4(v); }); }
            else if (nt < 16) { bf16_t* O = (bf16_t*)(ws + OFF_MQ); const int c0 = (nt - 12) * 128;
                FOR_ACC(acc, { *(u32x2*)(O + (size_t)(mt * 128 + m) * 512 + c0 + n) = pack4(v); }); }
            else { const int br = (nt - 16) >> 2, c0 = ((nt - 16) & 3) * 128; bf16_t* O = (bf16_t*)(ws + OFF_SZ) + (size_t)br * SEQ * 512;
                FOR_ACC(acc, { f32x4 s; s[0] = siluf_(v[0]); s[1] = siluf_(v[1]); s[2] = siluf_(v[2]); s[3] = siluf_(v[3]);
                               *(u32x2*)(O + (size_t)(mt * 128 + m) * 512 + c0 + n) = pack4(s); }); }
        }
    }
}

template <int D, bool FOX> __attribute__((always_inline))
__device__ __forceinline__ void flash_item(const bf16_t* __restrict__ Q, int ldq, const bf16_t* __restrict__ Kp, int ldk, const bf16_t* __restrict__ VT, int ldvt,
                           const float* __restrict__ F, int q0, int nkt, float scale, bf16_t* __restrict__ Y, int ldy, unsigned char* lds) {
    constexpr int KS = D / 16, DT = D / 32, KSTR = D + 8, VSTR = 72, KCPR = D / 8;
    constexpr int KCH = 64 * KCPR / 256, VCH = D * 8 / 256;
    bf16_t* Ks = (bf16_t*)lds; bf16_t* VTs = Ks + 64 * KSTR; float* Fk = (float*)(VTs + D * VSTR);
    const int tid = ltid(), lane = tid & 63, wid = tid >> 6, r = lane & 31, h = lane >> 5;
    const int qrow = q0 + wid * 32 + r;
    bf16x8 qf[KS];
#pragma unroll
    for (int s = 0; s < KS; ++s) qf[s] = *(const bf16x8*)(Q + (size_t)qrow * ldq + 16 * s + 8 * h);
    const float Fq = FOX ? F[qrow] : 0.f;
    f32x16 o[DT];
#pragma unroll
    for (int d = 0; d < DT; ++d)
#pragma unroll
        for (int i = 0; i < 16; ++i) o[d][i] = 0.f;
    float mrun = -INFINITY, lrun = 0.f;
    constexpr bool PREF = FOX;
    u32x4 rk[KCH], rv[VCH]; float rf = 0.f;
    if (PREF) {
#pragma unroll
    for (int i = 0; i < KCH; ++i) { const int c = tid + 256 * i, row = c / KCPR, ch = c % KCPR; rk[i] = *(const u32x4*)(Kp + (size_t)row * ldk + ch * 8); }
#pragma unroll
    for (int i = 0; i < VCH; ++i) { const int c = tid + 256 * i, row = c >> 3, ch = c & 7; rv[i] = *(const u32x4*)(VT + (size_t)row * ldvt + ch * 8); }
    if (FOX && tid < 64) rf = F[tid];
    }
    for (int kt = 0; kt < nkt; ++kt) {
        if (kt) __syncthreads();
        if (!PREF) {
            const int key0 = kt * 64;
#pragma unroll
            for (int i = 0; i < KCH; ++i) { const int c = tid + 256 * i, row = c / KCPR, ch = c % KCPR; rk[i] = *(const u32x4*)(Kp + (size_t)(key0 + row) * ldk + ch * 8); }
#pragma unroll
            for (int i = 0; i < VCH; ++i) { const int c = tid + 256 * i, row = c >> 3, ch = c & 7; rv[i] = *(const u32x4*)(VT + (size_t)row * ldvt + key0 + ch * 8); }
        }
#pragma unroll
        for (int i = 0; i < KCH; ++i) { const int c = tid + 256 * i, row = c / KCPR, ch = c % KCPR; *(u32x4*)(Ks + row * KSTR + ch * 8) = rk[i]; }
#pragma unroll
        for (int i = 0; i < VCH; ++i) { const int c = tid + 256 * i, row = c >> 3, ch = c & 7; *(u32x4*)(VTs + row * VSTR + ch * 8) = rv[i]; }
        if (FOX && tid < 64) Fk[tid] = rf;
        __syncthreads();
        if (PREF && kt + 1 < nkt) {
            const int key0 = (kt + 1) * 64;
#pragma unroll
            for (int i = 0; i < KCH; ++i) { const int c = tid + 256 * i, row = c / KCPR, ch = c % KCPR; rk[i] = *(const u32x4*)(Kp + (size_t)(key0 + row) * ldk + ch * 8); }
#pragma unroll
            for (int i = 0; i < VCH; ++i) { const int c = tid + 256 * i, row = c >> 3, ch = c & 7; rv[i] = *(const u32x4*)(VT + (size_t)row * ldvt + key0 + ch * 8); }
            if (FOX && tid < 64) rf = F[key0 + tid];
        }
#pragma unroll
        for (int sub = 0; sub < 2; ++sub) {
            f32x16 st;
#pragma unroll
            for (int i = 0; i < 16; ++i) st[i] = 0.f;
#pragma unroll
            for (int s = 0; s < KS; ++s) { const bf16x8 kf = *(const bf16x8*)(Ks + (sub * 32 + r) * KSTR + 16 * s + 8 * h); st = mfma32(kf, qf[s], st); }
            const int kbase = kt * 64 + sub * 32;
            float mx = -INFINITY;
#pragma unroll
            for (int i = 0; i < 16; ++i) {
                const int krow = (i & 3) + 8 * (i >> 2) + 4 * h;
                float v = st[i] * scale;
                if (FOX) { v += Fq - Fk[sub * 32 + krow]; if (kbase + krow > qrow) v = -INFINITY; }
                st[i] = v; mx = fmaxf(mx, v);
            }
            mx = fmaxf(mx, __shfl_xor(mx, 32));
            const float mnew = fmaxf(mrun, mx);
            const float alpha = __expf(mrun - mnew);
            float ps = 0.f;
#pragma unroll
            for (int i = 0; i < 16; ++i) { const float pv = __expf(st[i] - mnew); st[i] = pv; ps += pv; }
            lrun = lrun * alpha + ps; mrun = mnew;
#pragma unroll
            for (int d = 0; d < DT; ++d) o[d] = o[d] * alpha;
            bf16x8 pf[2];
#pragma unroll
            for (int s2 = 0; s2 < 2; ++s2) { u32x4 u; u.x = pack2(st[8 * s2 + 0], st[8 * s2 + 1]); u.y = pack2(st[8 * s2 + 2], st[8 * s2 + 3]); u.z = pack2(st[8 * s2 + 4], st[8 * s2 + 5]); u.w = pack2(st[8 * s2 + 6], st[8 * s2 + 7]);
                pf[s2] = __builtin_bit_cast(bf16x8, u); }
#pragma unroll
            for (int d = 0; d < DT; ++d)
#pragma unroll
                for (int s2 = 0; s2 < 2; ++s2) {
                    const bf16_t* vp = VTs + (d * 32 + r) * VSTR + sub * 32 + 16 * s2 + 4 * h;
                    const u32x2 lo = *(const u32x2*)vp, hi = *(const u32x2*)(vp + 8);
                    u32x4 u; u.x = lo.x; u.y = lo.y; u.z = hi.x; u.w = hi.y;
                    o[d] = mfma32(__builtin_bit_cast(bf16x8, u), pf[s2], o[d]);
                }
        }
    }
    const float ltot = lrun + __shfl_xor(lrun, 32);
    const float inv = 1.0f / ltot;
#pragma unroll
    for (int d = 0; d < DT; ++d)
#pragma unroll
        for (int g4 = 0; g4 < 4; ++g4) {
            bf16_t* yp = Y + (size_t)qrow * ldy + d * 32 + 8 * g4 + 4 * h;
            const u32x2 zz = *(const u32x2*)yp;
            u32x2 w; w.x = pack2(o[d][4 * g4 + 0] * inv * lo16(zz.x), o[d][4 * g4 + 1] * inv * hi16(zz.x));
            w.y = pack2(o[d][4 * g4 + 2] * inv * lo16(zz.y), o[d][4 * g4 + 3] * inv * hi16(zz.y));
            *(u32x2*)yp = w;
        }
    __syncthreads();
}

__device__ __forceinline__ void gdn_scan(const Params& p, int hd, int es, unsigned char* lds) {
    unsigned char* ws = lptr(p.ws);
    bf16_t* ST = (bf16_t*)lds;
    bf16_t* VN = ST + 32 * 136;
    const int tid = ltid(), lane = tid & 63, w = tid >> 6, lr = lane & 15, lg = lane >> 4;
    const int e0 = es * 32;
    for (int i = tid; i < 32 * 136 / 2; i += 256) ((unsigned*)ST)[i] = 0u;
    f32x4 Sacc[2][2];
#pragma unroll
    for (int a = 0; a < 2; ++a)
#pragma unroll
        for (int b = 0; b < 2; ++b) Sacc[a][b] = (f32x4){0.f, 0.f, 0.f, 0.f};
    bf16_t* SZB = (bf16_t*)(ws + OFF_SZ) + (size_t)1 * SEQ * 512;
    float* SSQ = (float*)(ws + OFF_SSQ);
    const float* EG = (const float*)(ws + OFF_EXPGL);
    __syncthreads();
    for (int n = 0; n < 256; ++n) {
        const unsigned char* item = ws + OFF_GDN + (size_t)(hd * 256 + n) * GDN_ITEM;
        const bf16_t* Wg = (const bf16_t*)item; const bf16_t* QD = (const bf16_t*)(item + 16384); const bf16_t* KDT = (const bf16_t*)(item + 32768);
        const bf16_t* UT = (const bf16_t*)(item + 49152); const bf16_t* AQK = (const bf16_t*)(item + 65536);
        bf16x8 wf[4], qf[4], af[2], kf[2][2]; u32x2 uu[2];
#pragma unroll
        for (int s = 0; s < 4; ++s) { wf[s] = *(const bf16x8*)(Wg + (16 * w + lr) * 128 + 32 * s + 8 * lg); qf[s] = *(const bf16x8*)(QD + (16 * w + lr) * 128 + 32 * s + 8 * lg); }
#pragma unroll
        for (int s = 0; s < 2; ++s) af[s] = *(const bf16x8*)(AQK + (16 * w + lr) * 64 + 32 * s + 8 * lg);
#pragma unroll
        for (int dt = 0; dt < 2; ++dt)
#pragma unroll
            for (int s = 0; s < 2; ++s) kf[dt][s] = *(const bf16x8*)(KDT + (32 * w + 16 * dt + lr) * 64 + 32 * s + 8 * lg);
#pragma unroll
        for (int et = 0; et < 2; ++et) uu[et] = *(const u32x2*)(UT + (e0 + 16 * et + lr) * 64 + 16 * w + 4 * lg);
        const float egl = EG[hd * 256 + n];
        f32x4 p1[2], p2[2];
#pragma unroll
        for (int et = 0; et < 2; ++et) { p1[et] = (f32x4){0.f, 0.f, 0.f, 0.f}; p2[et] = (f32x4){0.f, 0.f, 0.f, 0.f}; }
#pragma unroll
        for (int s = 0; s < 4; ++s)
#pragma unroll
            for (int et = 0; et < 2; ++et) { const bf16x8 sb = *(const bf16x8*)(ST + (16 * et + lr) * 136 + 32 * s + 8 * lg);
                p1[et] = mfma16(wf[s], sb, p1[et]); p2[et] = mfma16(qf[s], sb, p2[et]); }
#pragma unroll
        for (int et = 0; et < 2; ++et) {
            f32x4 v; v[0] = lo16(uu[et].x) - p1[et][0]; v[1] = hi16(uu[et].x) - p1[et][1]; v[2] = lo16(uu[et].y) - p1[et][2]; v[3] = hi16(uu[et].y) - p1[et][3];
            *(u32x2*)(VN + (16 * et + lr) * 72 + 16 * w + 4 * lg) = pack4(v);
        }
        __syncthreads();
#pragma unroll
        for (int a = 0; a < 2; ++a)
#pragma unroll
            for (int b = 0; b < 2; ++b) Sacc[a][b] = Sacc[a][b] * egl;
#pragma unroll
        for (int s = 0; s < 2; ++s)
#pragma unroll
            for (int et = 0; et < 2; ++et) { const bf16x8 vb = *(const bf16x8*)(VN + (16 * et + lr) * 72 + 32 * s + 8 * lg);
                p2[et] = mfma16(af[s], vb, p2[et]);
                Sacc[0][et] = mfma16(kf[0][s], vb, Sacc[0][et]); Sacc[1][et] = mfma16(kf[1][s], vb, Sacc[1][et]); }
        {
            float rs[4] = {0.f, 0.f, 0.f, 0.f};
#pragma unroll
            for (int et = 0; et < 2; ++et)
#pragma unroll
                for (int rr = 0; rr < 4; ++rr) {
                    const float ov = p2[et][rr]; rs[rr] += ov * ov;
                    bf16_t* yp = SZB + (size_t)(n * 64 + 16 * w + 4 * lg + rr) * 512 + hd * 128 + e0 + 16 * et + lr;
                    *yp = f2bf(ov * bf2f(*yp));
                }
#pragma unroll
            for (int rr = 0; rr < 4; ++rr) {
                float v = rs[rr];
                v += __shfl_xor(v, 1); v += __shfl_xor(v, 2); v += __shfl_xor(v, 4); v += __shfl_xor(v, 8);
                if (lr == 0) atomicAdd(SSQ + (size_t)(n * 64 + 16 * w + 4 * lg + rr) * 4 + hd, v);
            }
        }
#pragma unroll
        for (int dt = 0; dt < 2; ++dt)
#pragma unroll
            for (int et = 0; et < 2; ++et) *(u32x2*)(ST + (16 * et + lr) * 136 + 32 * w + 16 * dt + 4 * lg) = pack4(Sacc[dt][et]);
        __syncthreads();
    }
}

__device__ __forceinline__ void phase_c(const Params& p, unsigned char* lds) {
    unsigned char* ws = lptr(p.ws); const int bid = lbid();
    if (bid < 16) gdn_scan(p, bid >> 2, bid & 3, lds);
    unsigned* ctr = (unsigned*)(ws + OFF_CTR);
    __shared__ unsigned s_item;
    for (;;) {
        __syncthreads();
        if (ltid() == 0) s_item = atomicAdd(ctr, 1u);
        __syncthreads();
        const unsigned it = s_item;
        if (it >= 1024u + 512u) break;
        if (it < 1024u) {
            const int qb = 127 - (int)(it >> 3), hd = it & 7;
            flash_item<64, true>((const bf16_t*)(ws + OFF_AQ) + hd * 64, 512, (const bf16_t*)(ws + OFF_AK) + hd * 64, 512,
                                 (const bf16_t*)(ws + OFF_AVT) + (size_t)hd * 64 * SEQ, SEQ, (const float*)(ws + OFF_F) + (size_t)hd * SEQ,
                                 qb * 128, 2 * qb + 2, 0.125f, (bf16_t*)(ws + OFF_SZ) + hd * 64, 512, lds);
        } else {
            const int j = it - 1024, qb = j >> 2, mh = j & 3;
            flash_item<128, false>((const bf16_t*)(ws + OFF_MQ) + mh * 128, 512, (const bf16_t*)(ws + OFF_MK) + mh * 128, 512,
                                   (const bf16_t*)(ws + OFF_MVT) + (size_t)mh * 128 * 256, 256, nullptr,
                                   qb * 128, 4, 0.08838834764831845f, (bf16_t*)(ws + OFF_SZ) + (size_t)2 * SEQ * 512 + mh * 128, 512, lds);
        }
    }
}

__device__ __forceinline__ void phase_e(const Params& p, int layer) {
    unsigned char* ws = lptr(p.ws);
    bf16_t* SZB = (bf16_t*)(ws + OFF_SZ) + (size_t)SEQ * 512;
    const float* SSQ = (const float*)(ws + OFF_SSQ);
    const float* gg = p.gdn_norm_g + layer * 128;
    const int total = SEQ * 512 / 8;
    for (int i = lbid() * 256 + ltid(); i < total; i += gridDim.x * 256) {
        const int row = i >> 6, c8 = (i & 63) * 8, hd = c8 >> 7, e = c8 & 127;
        const float rstd = rsqrtf(SSQ[row * 4 + hd] * (1.0f / 128.0f) + EPSV);
        u32x4 u = *(const u32x4*)(SZB + (size_t)row * 512 + c8);
#pragma unroll
        for (int q = 0; q < 4; ++q) u[q] = pack2(lo16(u[q]) * rstd * gg[e + 2 * q], hi16(u[q]) * rstd * gg[e + 2 * q + 1]);
        *(u32x4*)(SZB + (size_t)row * 512 + c8) = u;
    }
}

__device__ __forceinline__ void phase_d1(const Params& p, int layer, unsigned char* lds) {
    unsigned char* ws = lptr(p.ws); const int bid = lbid(), nb = gridDim.x;
    const bf16_t* H = (const bf16_t*)(ws + OFF_H); const bf16_t* WIN = (const bf16_t*)(ws + OFF_WIN); const bf16_t* WBR = (const bf16_t*)(ws + OFF_WBR);
    const bf16_t* Yb = (const bf16_t*)(ws + OFF_SZ);
    const float* bm = p.b_merge + layer * 3072;
    bf16_t* MG = (bf16_t*)(ws + OFF_MERGED);
    for (int it = bid; it < 1024; it += nb) {
        const int mt = it >> 3, nt = it & 7;
        f32x4 mg[4][4]; ZERO_ACC(mg);
#pragma unroll 1
        for (int br = 0; br < 3; ++br) {
            f32x4 acc[4][4]; ZERO_ACC(acc);
            gemm_acc(H + (size_t)mt * 128 * DM, DM, WIN + (size_t)(5120 + br * 1024 + nt * 128) * DM, DM, DM, lds, acc);
            unsigned* GP = (unsigned*)(lds + 36864) + ltid();
            {
                const int lane_ = ltid() & 63, wid_ = ltid() >> 6, wc_ = wid_ & 1;
#pragma unroll
                for (int i_ = 0; i_ < 4; ++i_)
#pragma unroll
                    for (int j_ = 0; j_ < 4; ++j_) {
                        const int n = wc_ * 64 + j_ * 16 + 4 * (lane_ >> 4);
                        const f32x4 bv = *(const f32x4*)(bm + br * 1024 + nt * 128 + n);
                        const f32x4 v = acc[i_][j_];
                        GP[((i_ * 4 + j_) * 2 + 0) * 256] = pack2(sigmoidf_(v[0] + bv[0]), sigmoidf_(v[1] + bv[1]));
                        GP[((i_ * 4 + j_) * 2 + 1) * 256] = pack2(sigmoidf_(v[2] + bv[2]), sigmoidf_(v[3] + bv[3]));
                    }
            }
            ZERO_ACC(acc);
            gemm_acc(Yb + (size_t)br * SEQ * 512 + (size_t)mt * 128 * 512, 512, WBR + (size_t)br * 1024 * 512 + (size_t)nt * 128 * 512, 512, 512, lds, acc);
#pragma unroll
            for (int i_ = 0; i_ < 4; ++i_)
#pragma unroll
                for (int j_ = 0; j_ < 4; ++j_) {
                    const unsigned g0 = GP[((i_ * 4 + j_) * 2 + 0) * 256], g1 = GP[((i_ * 4 + j_) * 2 + 1) * 256];
                    mg[i_][j_][0] += lo16(g0) * acc[i_][j_][0]; mg[i_][j_][1] += hi16(g0) * acc[i_][j_][1];
                    mg[i_][j_][2] += lo16(g1) * acc[i_][j_][2]; mg[i_][j_][3] += hi16(g1) * acc[i_][j_][3];
                }
        }
        FOR_ACC(mg, { *(u32x2*)(MG + (size_t)(mt * 128 + m) * DM + nt * 128 + n) = pack4(v); });
    }
}

__device__ __forceinline__ void phase_d2(const Params& p, int layer, unsigned char* lds) {
    unsigned char* ws = lptr(p.ws); const int bid = lbid(), nb = gridDim.x;
    const bf16_t* MG = (const bf16_t*)(ws + OFF_MERGED); const bf16_t* WO = (const bf16_t*)(ws + OFF_WOUT);
    const float* xin = layer == 0 ? p.x : p.out;
    for (int it = bid; it < 1024; it += nb) {
        const int mt = it >> 3, nt = it & 7;
        f32x4 acc[4][4]; ZERO_ACC(acc);
        gemm_acc(MG + (size_t)mt * 128 * DM, DM, WO + (size_t)nt * 128 * DM, DM, DM, lds, acc);
        FOR_ACC(acc, { const size_t off = (size_t)(mt * 128 + m) * DM + nt * 128 + n; const f32x4 xv = *(const f32x4*)(xin + off); *(f32x4*)(p.out + off) = xv + v; });
    }
}

__device__ __forceinline__ void phase_final(const Params& p) {
    const int tid = ltid(), lane = tid & 63, wid = tid >> 6;
    f32x4 g[4];
#pragma unroll
    for (int i = 0; i < 4; ++i) g[i] = *(const f32x4*)(p.final_norm_g + 4 * lane + 256 * i);
    for (int row = lbid() * 4 + wid; row < SEQ; row += gridDim.x * 4) {
        f32x4 xv[4]; float ss = 0.f;
#pragma unroll
        for (int i = 0; i < 4; ++i) { xv[i] = *(const f32x4*)(p.out + (size_t)row * DM + 4 * lane + 256 * i); ss += xv[i][0] * xv[i][0] + xv[i][1] * xv[i][1] + xv[i][2] * xv[i][2] + xv[i][3] * xv[i][3]; }
        ss = wave_sum(ss);
        const float rstd = rsqrtf(ss * (1.0f / DM) + EPSV);
#pragma unroll
        for (int i = 0; i < 4; ++i) *(f32x4*)(p.out + (size_t)row * DM + 4 * lane + 256 * i) = xv[i] * rstd * g[i];
    }
}

#define LAYER_BODY(layer) do { \
        phase_a(p, layer, lds); \
        grid.sync(); \
        phase_b1(p, lds); \
        grid.sync(); \
        for (int it = lbid(); it < 1024; it += gridDim.x) gdn_chunk(p, layer, it >> 8, it & 255, lds); \
        grid.sync(); \
        phase_b2(p, lds); \
        grid.sync(); \
        phase_c(p, lds); \
        grid.sync(); \
        phase_e(p, layer); \
        grid.sync(); \
        phase_d1(p, layer, lds); \
        grid.sync(); \
        phase_d2(p, layer, lds); \
        grid.sync(); \
     \
} while (0)
__global__ void __launch_bounds__(256, 2) fwd_megakernel(Params p) {
    __shared__ __attribute__((aligned(16))) unsigned char lds[LDS_BYTES];
    cg::grid_group grid = cg::this_grid();
    LAYER_BODY(0);
    LAYER_BODY(1);
    phase_final(p);
}

extern "C" void kernel_launch(void* const* d_in, const int* in_sizes, int n_in, void* d_out, int out_size, void* d_ws, size_t ws_size, hipStream_t stream) {
    static int grid_blocks = 0;
    if (!grid_blocks) {
        int dev = 0, cus = 0, per_cu = 0;
        hipGetDevice(&dev);
        hipDeviceGetAttribute(&cus, hipDeviceAttributeMultiprocessorCount, dev);
        hipOccupancyMaxActiveBlocksPerMultiprocessor(&per_cu, fwd_megakernel, 256, 0);
        if (per_cu > 2) per_cu = 2;
        if (per_cu < 1) per_cu = 1;
        grid_blocks = cus * per_cu;
    }
    Params p{};
    p.x = (const float*)d_in[0]; p.mem = (const float*)d_in[1]; p.norm_g = (const float*)d_in[2]; p.w_in = (const float*)d_in[3];
    p.b_fg = (const float*)d_in[4]; p.b_merge = (const float*)d_in[5]; p.conv_w = (const float*)d_in[6]; p.a_log = (const float*)d_in[7];
    p.dt_bias = (const float*)d_in[8]; p.gdn_norm_g = (const float*)d_in[9]; p.mem_norm_g = (const float*)d_in[10]; p.w_mem_kv = (const float*)d_in[11];
    p.w_branch = (const float*)d_in[12]; p.w_out = (const float*)d_in[13]; p.final_norm_g = (const float*)d_in[14];
    p.out = (float*)d_out; p.ws = (unsigned char*)d_ws;
    void* args[] = {&p};
    hipError_t e = hipLaunchCooperativeKernel((void*)fwd_megakernel, dim3(grid_blocks), dim3(256), args, 0, stream);
    if (e != hipSuccess) fprintf(stderr, "cooperative launch failed: %s (grid %d)\n", hipGetErrorString(e), grid_blocks);
}
```

```cpp
#include <hip/hip_runtime.h>
#include <hip/hip_cooperative_groups.h>
#include <cstdio>
#include <cstdint>
namespace cg = cooperative_groups;

typedef unsigned short bf16_t;
typedef short bf16x8 __attribute__((ext_vector_type(8)));
typedef float f32x4 __attribute__((ext_vector_type(4)));
typedef float f32x16 __attribute__((ext_vector_type(16)));
typedef unsigned u32x4 __attribute__((ext_vector_type(4)));
typedef unsigned u32x2 __attribute__((ext_vector_type(2)));

#define SEQ 16384
#define DM 1024
#define NIN 8208
#define EPSV 1e-6f

#define OFF_WIN   0ull
#define OFF_WBR   16777216ull
#define OFF_WOUT  19922944ull
#define OFF_WMEM  22020096ull
#define OFF_H     24117248ull
#define OFF_BRAW  57671680ull
#define OFF_AQ    (OFF_BRAW)
#define OFF_AK    (OFF_BRAW + 16777216ull)
#define OFF_AVT   (OFF_BRAW + 33554432ull)
#define OFF_MERGED (OFF_BRAW)
#define OFF_GDN   108003328ull
#define OFF_MQ    183500800ull
#define OFF_SZ    200278016ull
#define OFF_F     250609664ull
#define OFF_GLOG  (OFF_F + 524288ull)
#define OFF_BETA  (OFF_GLOG + 262144ull)
#define OFF_SSQ   (OFF_BETA + 262144ull)
#define OFF_MEMN  (OFF_SSQ + 262144ull)
#define OFF_MK    (OFF_MEMN + 524288ull)
#define OFF_MVT   (OFF_MK + 262144ull)
#define OFF_EXPGL (OFF_MVT + 262144ull)
#define OFF_CTR   (OFF_EXPGL + 4096ull)
#define GDN_ITEM 73728
#ifndef PROBE_IDX
#define PROBE_IDX -1
#endif
#define OFF_TS (OFF_CTR + 1024ull)
#if PROBE_IDX >= 0
#define TSTAMP(i) do { if (__builtin_amdgcn_workgroup_id_x() == 0 && __builtin_amdgcn_workitem_id_x() == 0) ((unsigned long long*)(p.ws + OFF_TS))[i] = __builtin_amdgcn_s_memrealtime(); } while (0)
#else
#define TSTAMP(i) do { } while (0)
#endif

#define LDS_BYTES 69632

struct Params {
    const float* x; const float* mem; const float* norm_g; const float* w_in; const float* b_fg; const float* b_merge;
    const float* conv_w; const float* a_log; const float* dt_bias; const float* gdn_norm_g; const float* mem_norm_g;
    const float* w_mem_kv; const float* w_branch; const float* w_out; const float* final_norm_g;
    float* out; unsigned char* ws;
};

__device__ __forceinline__ int ltid() { int t = __builtin_amdgcn_workitem_id_x(); asm volatile("" : "+v"(t)); return t; }
__device__ __forceinline__ int lbid() { int t = __builtin_amdgcn_workgroup_id_x(); asm volatile("" : "+s"(t)); return t; }
__device__ __forceinline__ unsigned char* lptr(unsigned char* q) { unsigned long long z = 0ull; asm volatile("" : "+s"(z)); return q + z; }
__device__ __forceinline__ float bf2f(bf16_t b) { return __uint_as_float(((unsigned)b) << 16); }
__device__ __forceinline__ bf16_t f2bf(float f) { unsigned u = __float_as_uint(f); u += 0x7fffu + ((u >> 16) & 1u); return (bf16_t)(u >> 16); }
__device__ __forceinline__ unsigned pack2(float lo, float hi) { return (unsigned)f2bf(lo) | ((unsigned)f2bf(hi) << 16); }
__device__ __forceinline__ u32x2 pack4(f32x4 v) { u32x2 r; r.x = pack2(v[0], v[1]); r.y = pack2(v[2], v[3]); return r; }
__device__ __forceinline__ float lo16(unsigned u) { return __uint_as_float(u << 16); }
__device__ __forceinline__ float hi16(unsigned u) { return __uint_as_float(u & 0xffff0000u); }
__device__ __forceinline__ f32x4 mfma16(bf16x8 a, bf16x8 b, f32x4 c) { return __builtin_amdgcn_mfma_f32_16x16x32_bf16(a, b, c, 0, 0, 0); }
__device__ __forceinline__ f32x16 mfma32(bf16x8 a, bf16x8 b, f32x16 c) { return __builtin_amdgcn_mfma_f32_32x32x16_bf16(a, b, c, 0, 0, 0); }
__device__ __forceinline__ float sigmoidf_(float x) { return 1.0f / (1.0f + __expf(-x)); }
__device__ __forceinline__ float siluf_(float x) { return x / (1.0f + __expf(-x)); }
__device__ __forceinline__ float softplusf_(float x) { return fmaxf(x, 0.f) + log1pf(expf(-fabsf(x))); }
__device__ __forceinline__ float wave_sum(float v) {
#pragma unroll
    for (int o = 32; o >= 1; o >>= 1) v += __shfl_xor(v, o);
    return v;
}

__device__ __forceinline__ void gemm_acc(const bf16_t* __restrict__ A, int lda, const bf16_t* __restrict__ B, int ldb, int K,
                                         unsigned char* lds, f32x4 (&acc)[4][4]) {
    bf16_t* As = (bf16_t*)lds; bf16_t* Bs = As + 128 * 72;
    const int tid = ltid(), lane = tid & 63, wid = tid >> 6, wr = wid >> 1, wc = wid & 1, lr = lane & 15, lg = lane >> 4;
    u32x4 ra[4], rb[4];
    const int nk = K >> 6;
#pragma unroll
    for (int i = 0; i < 4; ++i) { const int c = tid + 256 * i, row = c >> 3, ch = c & 7;
        ra[i] = *(const u32x4*)(A + (size_t)row * lda + ch * 8); rb[i] = *(const u32x4*)(B + (size_t)row * ldb + ch * 8); }
    for (int kt = 0; kt < nk; ++kt) {
        if (kt) __syncthreads();
#pragma unroll
        for (int i = 0; i < 4; ++i) { const int c = tid + 256 * i, row = c >> 3, ch = c & 7;
            *(u32x4*)(As + row * 72 + ch * 8) = ra[i]; *(u32x4*)(Bs + row * 72 + ch * 8) = rb[i]; }
        __syncthreads();
        if (kt + 1 < nk) {
            const int k0 = (kt + 1) << 6;
#pragma unroll
            for (int i = 0; i < 4; ++i) { const int c = tid + 256 * i, row = c >> 3, ch = c & 7;
                ra[i] = *(const u32x4*)(A + (size_t)row * lda + k0 + ch * 8); rb[i] = *(const u32x4*)(B + (size_t)row * ldb + k0 + ch * 8); }
        }
#pragma unroll
        for (int s = 0; s < 2; ++s) {
            bf16x8 bfr[4];
#pragma unroll
            for (int j = 0; j < 4; ++j) bfr[j] = *(const bf16x8*)(Bs + (wc * 64 + j * 16 + lr) * 72 + s * 32 + lg * 8);
#pragma unroll
            for (int i = 0; i < 4; ++i) {
                const bf16x8 af = *(const bf16x8*)(As + (wr * 64 + i * 16 + lr) * 72 + s * 32 + lg * 8);
#pragma unroll
                for (int j = 0; j < 4; ++j) acc[i][j] = mfma16(bfr[j], af, acc[i][j]);
            }
        }
    }
    __syncthreads();
}
#define ZERO_ACC(acc) _Pragma("unroll") for (int i_ = 0; i_ < 4; ++i_) _Pragma("unroll") for (int j_ = 0; j_ < 4; ++j_) acc[i_][j_] = (f32x4){0.f, 0.f, 0.f, 0.f}
#define FOR_ACC(acc, BODY) do { const int lane_ = ltid() & 63, wid_ = ltid() >> 6, wr_ = wid_ >> 1, wc_ = wid_ & 1; \
    _Pragma("unroll") for (int i_ = 0; i_ < 4; ++i_) _Pragma("unroll") for (int j_ = 0; j_ < 4; ++j_) { \
        const int m = wr_ * 64 + i_ * 16 + (lane_ & 15), n = wc_ * 64 + j_ * 16 + 4 * (lane_ >> 4); f32x4& v = acc[i_][j_]; BODY } } while (0)

__device__ __forceinline__ void transpose_tile(const float* __restrict__ src, int ldsrc, int k0, int c0, bf16_t* __restrict__ dst, int lddst, int n0, unsigned char* lds) {
    float* T = (float*)lds;
    const int tid = ltid();
#pragma unroll
    for (int i = 0; i < 16; ++i) { const int k = (tid >> 6) + 4 * i, n = tid & 63; T[k * 65 + n] = src[(size_t)(k0 + k) * ldsrc + c0 + n]; }
    __syncthreads();
#pragma unroll
    for (int i = 0; i < 8; ++i) { const int n = (tid >> 5) + 8 * i, k = 2 * (tid & 31);
        *(unsigned*)(dst + (size_t)(n0 + n) * lddst + k0 + k) = pack2(T[k * 65 + n], T[(k + 1) * 65 + n]); }
    __syncthreads();
}
__device__ __forceinline__ int win_orig_col(int nr) {
    if (nr < 1536) return 2056 + nr;
    if (nr < 3072) return nr - 1536;
    if (nr < 3584) return 4112 + (nr - 3072);
    if (nr < 4096) return 1544 + (nr - 3584);
    if (nr < 4608) return 3600 + (nr - 4096);
    if (nr < 5120) return 4624 + (nr - 4608);
    return 5136 + (nr - 5120);
}

__device__ __forceinline__ void phase_a(const Params& p, int layer, unsigned char* lds) {
    const int tid = ltid(), lane = tid & 63, wid = tid >> 6, bid = lbid(), nb = gridDim.x;
    unsigned char* ws = lptr(p.ws);
    const float* xin = layer == 0 ? p.x : p.out;
    const float* w_in = p.w_in + (size_t)layer * DM * NIN;
    {
        float* ssq = (float*)(ws + OFF_SSQ);
        for (int i = bid * 256 + tid; i < 65536; i += nb * 256) ssq[i] = 0.f;
        if (bid == 0 && tid < 64) ((unsigned*)(ws + OFF_CTR))[tid] = 0u;
    }
    float* Wsm = (float*)lds;
    for (int k = tid; k < 1024; k += 256) {
        const float* r = w_in + (size_t)k * NIN;
        f32x4 a0 = *(const f32x4*)(r + 1536), a1 = *(const f32x4*)(r + 1540), b0 = *(const f32x4*)(r + 3592), b1 = *(const f32x4*)(r + 3596);
#pragma unroll
        for (int q = 0; q < 4; ++q) { Wsm[q * 1024 + k] = a0[q]; Wsm[(4 + q) * 1024 + k] = a1[q]; Wsm[(8 + q) * 1024 + k] = b0[q]; Wsm[(12 + q) * 1024 + k] = b1[q]; }
    }
    __syncthreads();
    {
        const float* ng = p.norm_g + layer * DM;
        f32x4 g[4];
#pragma unroll
        for (int i = 0; i < 4; ++i) g[i] = *(const f32x4*)(ng + 4 * lane + 256 * i);
        bf16_t* H = (bf16_t*)(ws + OFF_H);
        float* Fb = (float*)(ws + OFF_F); float* GL = (float*)(ws + OFF_GLOG); float* BT = (float*)(ws + OFF_BETA);
        for (int row = bid * 4 + wid; row < SEQ; row += nb * 4) {
            asm volatile("" ::: "memory");
            f32x4 xv[4]; float ss = 0.f;
#pragma unroll
            for (int i = 0; i < 4; ++i) { xv[i] = *(const f32x4*)(xin + (size_t)row * DM + 4 * lane + 256 * i); ss += xv[i][0] * xv[i][0] + xv[i][1] * xv[i][1] + xv[i][2] * xv[i][2] + xv[i][3] * xv[i][3]; }
            ss = wave_sum(ss);
            const float rstd = rsqrtf(ss * (1.0f / DM) + EPSV);
#pragma unroll
            for (int i = 0; i < 4; ++i) { xv[i] = xv[i] * rstd * g[i]; *(u32x2*)(H + (size_t)row * DM + 4 * lane + 256 * i) = pack4(xv[i]); }
            float myv = 0.f;
#pragma unroll
            for (int c = 0; c < 16; ++c) {
                float d = 0.f;
#pragma unroll
                for (int i = 0; i < 4; ++i) { const f32x4 w = *(const f32x4*)(Wsm + c * 1024 + 4 * lane + 256 * i); d += xv[i][0] * w[0] + xv[i][1] * w[1] + xv[i][2] * w[2] + xv[i][3] * w[3]; }
                d = wave_sum(d);
                if (lane == c) myv = d;
            }
            if (lane < 8) { const float z = myv + p.b_fg[layer * 8 + lane]; Fb[(size_t)lane * SEQ + row] = -softplusf_(-z); }
            else if (lane < 12) { const int hd = lane - 8; GL[(size_t)hd * SEQ + row] = -expf(p.a_log[layer * 4 + hd]) * softplusf_(myv + p.dt_bias[layer * 4 + hd]); }
            else if (lane < 16) { const int hd = lane - 12; BT[(size_t)hd * SEQ + row] = 1.0f / (1.0f + expf(-myv)); }
        }
        const float* mg = p.mem_norm_g + layer * DM;
        bf16_t* MN = (bf16_t*)(ws + OFF_MEMN);
        for (int row = bid * 4 + wid; row < 256; row += nb * 4) {
            f32x4 xv[4]; float ss = 0.f;
#pragma unroll
            for (int i = 0; i < 4; ++i) { xv[i] = *(const f32x4*)(p.mem + (size_t)row * DM + 4 * lane + 256 * i); ss += xv[i][0] * xv[i][0] + xv[i][1] * xv[i][1] + xv[i][2] * xv[i][2] + xv[i][3] * xv[i][3]; }
            ss = wave_sum(ss);
            const float rstd = rsqrtf(ss * (1.0f / DM) + EPSV);
#pragma unroll
            for (int i = 0; i < 4; ++i) { const f32x4 gg = *(const f32x4*)(mg + 4 * lane + 256 * i); xv[i] = xv[i] * rstd * gg; *(u32x2*)(MN + (size_t)row * DM + 4 * lane + 256 * i) = pack4(xv[i]); }
        }
    }
    __syncthreads();
    for (int it = bid; it < 2944; it += nb) {
        if (it < 2048) { const int nt = it >> 4, kt = it & 15; transpose_tile(w_in, NIN, kt * 64, win_orig_col(nt * 64), (bf16_t*)(ws + OFF_WIN), 1024, nt * 64, lds); }
        else if (it < 2432) { const int j = it - 2048, br = j >> 7, r = j & 127, nt = r >> 3, kt = r & 7;
            transpose_tile(p.w_branch + ((size_t)layer * 3 + br) * 512 * 1024, 1024, kt * 64, nt * 64, (bf16_t*)(ws + OFF_WBR) + (size_t)br * 1024 * 512, 512, nt * 64, lds); }
        else if (it < 2688) { const int j = it - 2432, nt = j >> 4, kt = j & 15; transpose_tile(p.w_out + (size_t)layer * DM * DM, DM, kt * 64, nt * 64, (bf16_t*)(ws + OFF_WOUT), 1024, nt * 64, lds); }
        else { const int j = it - 2688, nt = j >> 4, kt = j & 15; transpose_tile(p.w_mem_kv + (size_t)layer * DM * DM, DM, kt * 64, nt * 64, (bf16_t*)(ws + OFF_WMEM), 1024, nt * 64, lds); }
    }
}

__device__ __forceinline__ void cumsum_head(float* F, unsigned char* lds) {
    double* part = (double*)lds;
    const int tid = ltid();
    double s = 0.0;
    for (int i = 0; i < 64; ++i) s += (double)F[tid * 64 + i];
    part[tid] = s;
    __syncthreads();
    if (tid == 0) { double run = 0.0; for (int i = 0; i < 256; ++i) { const double t = part[i]; part[i] = run; run += t; } }
    __syncthreads();
    double run = part[tid];
    for (int i = 0; i < 64; ++i) { run += (double)F[tid * 64 + i]; F[tid * 64 + i] = (float)run; }
    __syncthreads();
}

__device__ __forceinline__ void phase_b1(const Params& p, unsigned char* lds) {
    unsigned char* ws = lptr(p.ws); const int bid = lbid(), nb = gridDim.x;
    const bf16_t* H = (const bf16_t*)(ws + OFF_H); const bf16_t* WIN = (const bf16_t*)(ws + OFF_WIN);
    const bf16_t* WM = (const bf16_t*)(ws + OFF_WMEM); const bf16_t* MN = (const bf16_t*)(ws + OFF_MEMN);
    for (int it = bid; it < 24 + 1536; it += nb) {
        if (it < 8) { cumsum_head((float*)(ws + OFF_F) + (size_t)it * SEQ, lds); continue; }
        f32x4 acc[4][4]; ZERO_ACC(acc);
        if (it < 16) {
            const int j = it - 8, mt = j >> 2, nt = j & 3;
            gemm_acc(MN + (size_t)mt * 128 * DM, DM, WM + (size_t)nt * 128 * DM, DM, DM, lds, acc);
            bf16_t* O = (bf16_t*)(ws + OFF_MK);
            FOR_ACC(acc, { *(u32x2*)(O + (size_t)(mt * 128 + m) * 512 + nt * 128 + n) = pack4(v); });
        } else if (it < 24) {
            const int j = it - 16, mt = j >> 1, nt = j & 1;
            gemm_acc(WM + (size_t)(512 + mt * 128) * DM, DM, MN + (size_t)nt * 128 * DM, DM, DM, lds, acc);
            bf16_t* O = (bf16_t*)(ws + OFF_MVT);
            FOR_ACC(acc, { *(u32x2*)(O + (size_t)(mt * 128 + m) * 256 + nt * 128 + n) = pack4(v); });
        } else {
            const int j = it - 24, mt = j / 12, nt = j % 12;
            gemm_acc(H + (size_t)mt * 128 * DM, DM, WIN + (size_t)nt * 128 * DM, DM, DM, lds, acc);
            bf16_t* O = (bf16_t*)(ws + OFF_BRAW);
            FOR_ACC(acc, { *(u32x2*)(O + (size_t)(mt * 128 + m) * 1536 + nt * 128 + n) = pack4(v); });
        }
    }
}

__device__ __forceinline__ void conv_col(const bf16_t* __restrict__ braw, int t0, int ch, const float* __restrict__ cw, float (&x)[64]) {
    const float w0 = cw[ch], w1 = cw[1536 + ch], w2 = cw[3072 + ch], w3 = cw[4608 + ch];
    float r0 = 0.f, r1 = 0.f, r2 = 0.f;
    if (t0 > 0) { r0 = bf2f(braw[(size_t)(t0 - 3) * 1536 + ch]); r1 = bf2f(braw[(size_t)(t0 - 2) * 1536 + ch]); r2 = bf2f(braw[(size_t)(t0 - 1) * 1536 + ch]); }
#pragma unroll
    for (int c = 0; c < 64; ++c) {
        if ((c & 15) == 0) asm volatile("" ::: "memory");
        const float r3 = bf2f(braw[(size_t)(t0 + c) * 1536 + ch]);
        const float v = w0 * r0 + w1 * r1 + w2 * r2 + w3 * r3;
        x[c] = siluf_(v);
        r0 = r1; r1 = r2; r2 = r3;
    }
}

__device__ __forceinline__ void gdn_chunk(const Params& p, int layer, int hd, int n, unsigned char* lds) {
    const int tid = ltid(), lane = tid & 63, wid = tid >> 6, col = tid & 127, half = tid >> 7;
    unsigned char* ws = lptr(p.ws);
    const bf16_t* braw = (const bf16_t*)(ws + OFF_BRAW);
    const float* cw = p.conv_w + (size_t)layer * 4 * 1536;
    const int t0 = n * 64;
    unsigned char* item = ws + OFF_GDN + (size_t)(hd * 256 + n) * GDN_ITEM;
    bf16_t* Wg = (bf16_t*)item; bf16_t* QD = (bf16_t*)(item + 16384); bf16_t* KDT = (bf16_t*)(item + 32768); bf16_t* UT = (bf16_t*)(item + 49152); bf16_t* AQK = (bf16_t*)(item + 65536);
    float* SQ = (float*)lds;
    float* PART = (float*)(lds + 66560);
    float* INV = PART + 256;
    float* Gs = INV + 128;
    float* Bs = Gs + 64;
    bf16_t* QB = (bf16_t*)lds;
    bf16_t* KB = QB + 64 * 136;
    float* AM = (float*)(lds + 34816);

    float x[64];
    conv_col(braw, t0, (half ? 512 : 0) + hd * 128 + col, cw, x);
#pragma unroll
    for (int c = 0; c < 64; ++c) SQ[(wid * 64 + c) * 65 + lane] = x[c] * x[c];
    if (tid < 64) {
        float g = ((const float*)(ws + OFF_GLOG))[(size_t)hd * SEQ + t0 + tid];
#pragma unroll
        for (int o = 1; o < 64; o <<= 1) { const float t = __shfl_up(g, o); if (lane >= o) g += t; }
        Gs[tid] = g; Bs[tid] = ((const float*)(ws + OFF_BETA))[(size_t)hd * SEQ + t0 + tid];
    }
    __syncthreads();
    { float s = 0.f;
#pragma unroll 8
      for (int j = 0; j < 64; ++j) s += SQ[(wid * 64 + lane) * 65 + j];
      PART[wid * 64 + lane] = s; }
    __syncthreads();
    if (tid < 64) INV[tid] = rsqrtf(PART[tid] + PART[64 + tid] + EPSV) * 0.08838834764831845f;
    else if (tid < 128) INV[tid] = rsqrtf(PART[128 + tid - 64] + PART[192 + tid - 64] + EPSV);
    __syncthreads();
    const float glast = Gs[63];
#pragma unroll
    for (int c = 0; c < 64; ++c) { if ((c & 15) == 0) asm volatile("" ::: "memory"); x[c] *= INV[half * 64 + c]; (half ? KB : QB)[c * 136 + col] = f2bf(x[c]); }
    if (half == 0) {
#pragma unroll
        for (int c = 0; c < 64; ++c) { if ((c & 15) == 0) asm volatile("" ::: "memory"); QD[c * 128 + col] = f2bf(x[c] * __expf(Gs[c])); }
        conv_col(braw, t0, 1024 + hd * 128 + col, cw, x);
#pragma unroll
        for (int c = 0; c < 64; ++c) x[c] *= Bs[c];
    } else {
#pragma unroll
        for (int c8 = 0; c8 < 8; ++c8) { u32x4 o;
#pragma unroll
            for (int q = 0; q < 4; ++q) { const int c = c8 * 8 + 2 * q; o[q] = pack2(x[c] * __expf(glast - Gs[c]), x[c + 1] * __expf(glast - Gs[c + 1])); }
            *(u32x4*)(KDT + col * 64 + c8 * 8) = o; }
#pragma unroll
        for (int c = 0; c < 64; ++c) { if ((c & 15) == 0) asm volatile("" ::: "memory"); x[c] *= Bs[c] * __expf(Gs[c]); }
    }
    if (tid == 0) ((float*)(ws + OFF_EXPGL))[hd * 256 + n] = __expf(glast);
    __syncthreads();
    {
        const int lr = lane & 15, lg = lane >> 4;
        f32x4 kk[4], qk[4];
#pragma unroll
        for (int j = 0; j < 4; ++j) { kk[j] = (f32x4){0.f, 0.f, 0.f, 0.f}; qk[j] = (f32x4){0.f, 0.f, 0.f, 0.f}; }
#pragma unroll
        for (int s = 0; s < 4; ++s) {
            const bf16x8 ka = *(const bf16x8*)(KB + (wid * 16 + lr) * 136 + s * 32 + lg * 8);
            const bf16x8 qa = *(const bf16x8*)(QB + (wid * 16 + lr) * 136 + s * 32 + lg * 8);
#pragma unroll
            for (int j = 0; j < 4; ++j) { const bf16x8 kb = *(const bf16x8*)(KB + (j * 16 + lr) * 136 + s * 32 + lg * 8);
                kk[j] = mfma16(ka, kb, kk[j]); qk[j] = mfma16(qa, kb, qk[j]); }
        }
#pragma unroll
        for (int j = 0; j < 4; ++j)
#pragma unroll
            for (int r = 0; r < 4; ++r) {
                const int c = wid * 16 + 4 * lg + r, s = j * 16 + lr;
                const float e = __expf(s <= c ? Gs[c] - Gs[s] : 0.f);
                AM[c * 68 + s] = (s < c) ? Bs[c] * kk[j][r] * e : 0.f;
                AQK[c * 64 + s] = f2bf((s <= c) ? qk[j][r] * e : 0.f);
            }
    }
    __syncthreads();
#pragma unroll
    for (int c = 1; c < 64; ++c) {
        if ((c & 1) == 0) asm volatile("" ::: "memory");
        float a = x[c];
#pragma unroll
        for (int s4 = 0; s4 < (c + 3) / 4; ++s4) {
            const f32x4 av = *(const f32x4*)(AM + c * 68 + 4 * s4);
#pragma unroll
            for (int q = 0; q < 4; ++q) if (4 * s4 + q < c) a -= av[q] * x[4 * s4 + q];
        }
        x[c] = a;
    }
    if (half == 0) {
#pragma unroll
        for (int c8 = 0; c8 < 8; ++c8) { u32x4 o;
#pragma unroll
            for (int q = 0; q < 4; ++q) o[q] = pack2(x[c8 * 8 + 2 * q], x[c8 * 8 + 2 * q + 1]);
            *(u32x4*)(UT + col * 64 + c8 * 8) = o; }
    } else {
#pragma unroll
        for (int c = 0; c < 64; ++c) Wg[c * 128 + col] = f2bf(x[c]);
    }
    __syncthreads();
}

__device__ __forceinline__ void phase_b2(const Params& p, unsigned char* lds) {
    unsigned char* ws = lptr(p.ws); const int bid = lbid(), nb = gridDim.x;
    const bf16_t* H = (const bf16_t*)(ws + OFF_H); const bf16_t* WIN = (const bf16_t*)(ws + OFF_WIN);
    for (int it = bid; it < 128 * 28; it += nb) {
        const int mt = it / 28, nt = it % 28;
        f32x4 acc[4][4]; ZERO_ACC(acc);
        const bf16_t* Wt = WIN + (size_t)(1536 + nt * 128) * DM;
        const bf16_t* Ht = H + (size_t)mt * 128 * DM;
        if (nt >= 8 && nt < 12) {
            gemm_acc(Wt, DM, Ht, DM, DM, lds, acc);
            bf16_t* O = (bf16_t*)(ws + OFF_AVT);
            FOR_ACC(acc, { *(u32x2*)(O + (size_t)((nt - 8) * 128 + m) * SEQ + mt * 128 + n) = pack4(v); });
        } else {
            gemm_acc(Ht, DM, Wt, DM, DM, lds, acc);
            if (nt < 8) { bf16_t* O = (bf16_t*)(ws + (nt < 4 ? OFF_AQ : OFF_AK)); const int c0 = (nt & 3) * 128;
                FOR_ACC(acc, { *(u32x2*)(O + (size_t)(mt * 128 + m) * 512 + c0 + n) = pack4(v); });
                if (nt >= 4) {
                    const int t_ = ltid(), lane_ = t_ & 63, wc_ = (t_ >> 6) & 1;
                    float mx = 0.f;
#pragma unroll
                    for (int i_ = 0; i_ < 4; ++i_) { float ss = 0.f;
#pragma unroll
                        for (int j_ = 0; j_ < 4; ++j_)
#pragma unroll
                            for (int q_ = 0; q_ < 4; ++q_) { const float r_ = bf2f(f2bf(acc[i_][j_][q_])); ss += r_ * r_; }
                        ss += __shfl_xor(ss, 16); ss += __shfl_xor(ss, 32); mx = fmaxf(mx, ss); }
                    mx = fmaxf(mx, __shfl_xor(mx, 1)); mx = fmaxf(mx, __shfl_xor(mx, 2)); mx = fmaxf(mx, __shfl_xor(mx, 4)); mx = fmaxf(mx, __shfl_xor(mx, 8));
                    if (lane_ == 0) atomicMax((unsigned*)(ws + OFF_CTR) + 16 + (nt & 3) * 2 + wc_, __float_as_uint(mx));
                } }
            else if (nt < 16) { bf16_t* O = (bf16_t*)(ws + OFF_MQ); const int c0 = (nt - 12) * 128;
                FOR_ACC(acc, { *(u32x2*)(O + (size_t)(mt * 128 + m) * 512 + c0 + n) = pack4(v); }); }
            else { const int br = (nt - 16) >> 2, c0 = ((nt - 16) & 3) * 128; bf16_t* O = (bf16_t*)(ws + OFF_SZ) + (size_t)br * SEQ * 512;
                FOR_ACC(acc, { f32x4 s; s[0] = siluf_(v[0]); s[1] = siluf_(v[1]); s[2] = siluf_(v[2]); s[3] = siluf_(v[3]);
                               *(u32x2*)(O + (size_t)(mt * 128 + m) * 512 + c0 + n) = pack4(s); }); }
        }
    }
}

template <int D, bool FOX> __attribute__((always_inline))
__device__ __forceinline__ void flash_item(const bf16_t* __restrict__ Q, int ldq, const bf16_t* __restrict__ Kp, int ldk, const bf16_t* __restrict__ VT, int ldvt,
                           const float* __restrict__ F, int q0, int nkt, float scale, float kmaxn, bf16_t* __restrict__ Y, int ldy, unsigned char* lds) {
    constexpr int KS = D / 16, DT = D / 32, KSTR = D + 8, VSTR = 72, KCPR = D / 8;
    constexpr int KCH = 64 * KCPR / 256, VCH = D * 8 / 256;
    bf16_t* Ks = (bf16_t*)lds; bf16_t* VTs = Ks + 64 * KSTR; float* Fk = (float*)(VTs + D * VSTR); unsigned* FLG = (unsigned*)(Fk + 64);
    const int tid = ltid(), lane = tid & 63, wid = tid >> 6, r = lane & 31, h = lane >> 5;
    const int qrow = q0 + wid * 32 + r;
    bf16x8 qf[KS];
#pragma unroll
    for (int s = 0; s < KS; ++s) qf[s] = *(const bf16x8*)(Q + (size_t)qrow * ldq + 16 * s + 8 * h);
    const float Fq = FOX ? F[qrow] : 0.f;
    float qkb = 0.f;
    if (FOX) { float ss = 0.f;
#pragma unroll
        for (int s_ = 0; s_ < KS; ++s_)
#pragma unroll
            for (int j_ = 0; j_ < 8; ++j_) { const float v_ = bf2f((bf16_t)qf[s_][j_]); ss += v_ * v_; }
        ss += __shfl_xor(ss, 32); qkb = sqrtf(ss) * kmaxn * scale * 1.001f + 0.1f; }
    f32x16 o[DT];
#pragma unroll
    for (int d = 0; d < DT; ++d)
#pragma unroll
        for (int i = 0; i < 16; ++i) o[d][i] = 0.f;
    float mrun = -INFINITY, lrun = 0.f;
    constexpr bool PREF = FOX;
    u32x4 rk[KCH], rv[VCH]; float rf = 0.f;
    if (PREF) {
        const int key0 = (nkt - 1) * 64;
#pragma unroll
    for (int i = 0; i < KCH; ++i) { const int c = tid + 256 * i, row = c / KCPR, ch = c % KCPR; rk[i] = *(const u32x4*)(Kp + (size_t)(key0 + row) * ldk + ch * 8); }
#pragma unroll
    for (int i = 0; i < VCH; ++i) { const int c = tid + 256 * i, row = c >> 3, ch = c & 7; rv[i] = *(const u32x4*)(VT + (size_t)row * ldvt + key0 + ch * 8); }
    if (FOX && tid < 64) rf = F[key0 + tid];
    }
    for (int kk_ = 0; kk_ < nkt; ++kk_) {
        const int kt = FOX ? (nkt - 1 - kk_) : kk_;
        if (kk_) __syncthreads();
        if (!PREF) {
            const int key0 = kt * 64;
#pragma unroll
            for (int i = 0; i < KCH; ++i) { const int c = tid + 256 * i, row = c / KCPR, ch = c % KCPR; rk[i] = *(const u32x4*)(Kp + (size_t)(key0 + row) * ldk + ch * 8); }
#pragma unroll
            for (int i = 0; i < VCH; ++i) { const int c = tid + 256 * i, row = c >> 3, ch = c & 7; rv[i] = *(const u32x4*)(VT + (size_t)row * ldvt + key0 + ch * 8); }
        }
#pragma unroll
        for (int i = 0; i < KCH; ++i) { const int c = tid + 256 * i, row = c / KCPR, ch = c % KCPR; *(u32x4*)(Ks + row * KSTR + ch * 8) = rk[i]; }
#pragma unroll
        for (int i = 0; i < VCH; ++i) { const int c = tid + 256 * i, row = c >> 3, ch = c & 7; *(u32x4*)(VTs + row * VSTR + ch * 8) = rv[i]; }
        if (FOX && tid < 64) Fk[tid] = rf;
        if (FOX) {
            bool need = true;
            if (kk_ >= 2) need = (qkb + Fq - F[kt * 64 + 63] - mrun) > -40.0f;
            const unsigned long long bal = __ballot(need);
            if (lane == 0) FLG[wid] = (bal != 0ull) ? 1u : 0u;
        }
        __syncthreads();
        if (FOX) { if ((FLG[0] | FLG[1] | FLG[2] | FLG[3]) == 0u) break; }
        if (PREF && kt > 0) {
            const int key0 = (kt - 1) * 64;
#pragma unroll
            for (int i = 0; i < KCH; ++i) { const int c = tid + 256 * i, row = c / KCPR, ch = c % KCPR; rk[i] = *(const u32x4*)(Kp + (size_t)(key0 + row) * ldk + ch * 8); }
#pragma unroll
            for (int i = 0; i < VCH; ++i) { const int c = tid + 256 * i, row = c >> 3, ch = c & 7; rv[i] = *(const u32x4*)(VT + (size_t)row * ldvt + key0 + ch * 8); }
            if (FOX && tid < 64) rf = F[key0 + tid];
        }
#pragma unroll
        for (int sub = 0; sub < 2; ++sub) {
            if (FOX && kt * 64 + sub * 32 > q0 + wid * 32 + 31) continue;
            f32x16 st;
#pragma unroll
            for (int i = 0; i < 16; ++i) st[i] = 0.f;
#pragma unroll
            for (int s = 0; s < KS; ++s) { const bf16x8 kf = *(const bf16x8*)(Ks + (sub * 32 + r) * KSTR + 16 * s + 8 * h); st = mfma32(kf, qf[s], st); }
            const int kbase = kt * 64 + sub * 32;
            float mx = -INFINITY;
#pragma unroll
            for (int i = 0; i < 16; ++i) {
                const int krow = (i & 3) + 8 * (i >> 2) + 4 * h;
                float v = st[i] * scale;
                if (FOX) { v += Fq - Fk[sub * 32 + krow]; if (kbase + krow > qrow) v = -INFINITY; }
                st[i] = v; mx = fmaxf(mx, v);
            }
            mx = fmaxf(mx, __shfl_xor(mx, 32));
            const float mnew = fmaxf(mrun, mx);
            const float msafe = (mnew == -INFINITY) ? 0.f : mnew;
            const float alpha = __expf(mrun - msafe);
            float ps = 0.f;
#pragma unroll
            for (int i = 0; i < 16; ++i) { const float pv = __expf(st[i] - msafe); st[i] = pv; ps += pv; }
            lrun = lrun * alpha + ps; mrun = mnew;
#pragma unroll
            for (int d = 0; d < DT; ++d) o[d] = o[d] * alpha;
            bf16x8 pf[2];
#pragma unroll
            for (int s2 = 0; s2 < 2; ++s2) { u32x4 u; u.x = pack2(st[8 * s2 + 0], st[8 * s2 + 1]); u.y = pack2(st[8 * s2 + 2], st[8 * s2 + 3]); u.z = pack2(st[8 * s2 + 4], st[8 * s2 + 5]); u.w = pack2(st[8 * s2 + 6], st[8 * s2 + 7]);
                pf[s2] = __builtin_bit_cast(bf16x8, u); }
#pragma unroll
            for (int d = 0; d < DT; ++d)
#pragma unroll
                for (int s2 = 0; s2 < 2; ++s2) {
                    const bf16_t* vp = VTs + (d * 32 + r) * VSTR + sub * 32 + 16 * s2 + 4 * h;
                    const u32x2 lo = *(const u32x2*)vp, hi = *(const u32x2*)(vp + 8);
                    u32x4 u; u.x = lo.x; u.y = lo.y; u.z = hi.x; u.w = hi.y;
                    o[d] = mfma32(__builtin_bit_cast(bf16x8, u), pf[s2], o[d]);
                }
        }
    }
    const float ltot = lrun + __shfl_xor(lrun, 32);
    const float inv = 1.0f / ltot;
#pragma unroll
    for (int d = 0; d < DT; ++d)
#pragma unroll
        for (int g4 = 0; g4 < 4; ++g4) {
            bf16_t* yp = Y + (size_t)qrow * ldy + d * 32 + 8 * g4 + 4 * h;
            const u32x2 zz = *(const u32x2*)yp;
            u32x2 w; w.x = pack2(o[d][4 * g4 + 0] * inv * lo16(zz.x), o[d][4 * g4 + 1] * inv * hi16(zz.x));
            w.y = pack2(o[d][4 * g4 + 2] * inv * lo16(zz.y), o[d][4 * g4 + 3] * inv * hi16(zz.y));
            *(u32x2*)yp = w;
        }
    __syncthreads();
}

#define LDS_BARRIER() do { asm volatile("s_waitcnt lgkmcnt(0)" ::: "memory"); __builtin_amdgcn_s_barrier(); asm volatile("" ::: "memory"); } while (0)
struct ScanOps { bf16x8 wf[4], qf[4], af[2], kf[2][2]; u32x2 uu[2]; float egl; bf16_t sz[2][4]; };
__device__ __forceinline__ void scan_load(ScanOps& o, const unsigned char* ws, int hd, int n, int e0, int w, int lr, int lg) {
    const unsigned char* item = ws + OFF_GDN + (size_t)(hd * 256 + n) * GDN_ITEM;
    const bf16_t* Wg = (const bf16_t*)item; const bf16_t* QD = (const bf16_t*)(item + 16384); const bf16_t* KDT = (const bf16_t*)(item + 32768);
    const bf16_t* UT = (const bf16_t*)(item + 49152); const bf16_t* AQK = (const bf16_t*)(item + 65536);
#pragma unroll
    for (int s = 0; s < 4; ++s) { o.wf[s] = *(const bf16x8*)(Wg + (16 * w + lr) * 128 + 32 * s + 8 * lg); o.qf[s] = *(const bf16x8*)(QD + (16 * w + lr) * 128 + 32 * s + 8 * lg); }
#pragma unroll
    for (int s = 0; s < 2; ++s) o.af[s] = *(const bf16x8*)(AQK + (16 * w + lr) * 64 + 32 * s + 8 * lg);
#pragma unroll
    for (int dt = 0; dt < 2; ++dt)
#pragma unroll
        for (int s = 0; s < 2; ++s) o.kf[dt][s] = *(const bf16x8*)(KDT + (32 * w + 16 * dt + lr) * 64 + 32 * s + 8 * lg);
#pragma unroll
    for (int et = 0; et < 2; ++et) o.uu[et] = *(const u32x2*)(UT + (e0 + 16 * et + lr) * 64 + 16 * w + 4 * lg);
    o.egl = ((const float*)(ws + OFF_EXPGL))[hd * 256 + n];
    const bf16_t* SZB = (const bf16_t*)(ws + OFF_SZ) + (size_t)1 * SEQ * 512;
#pragma unroll
    for (int et = 0; et < 2; ++et)
#pragma unroll
        for (int rr = 0; rr < 4; ++rr) o.sz[et][rr] = SZB[(size_t)(n * 64 + 16 * w + 4 * lg + rr) * 512 + hd * 128 + e0 + 16 * et + lr];
}
__device__ __forceinline__ void gdn_scan(const Params& p, int hd, int es, unsigned char* lds) {
    unsigned char* ws = lptr(p.ws);
    bf16_t* ST = (bf16_t*)lds;
    bf16_t* VN = ST + 32 * 136;
    const int tid = ltid(), lane = tid & 63, w = tid >> 6, lr = lane & 15, lg = lane >> 4;
    const int e0 = es * 32;
    for (int i = tid; i < 32 * 136 / 2; i += 256) ((unsigned*)ST)[i] = 0u;
    f32x4 Sacc[2][2];
#pragma unroll
    for (int a = 0; a < 2; ++a)
#pragma unroll
        for (int b = 0; b < 2; ++b) Sacc[a][b] = (f32x4){0.f, 0.f, 0.f, 0.f};
    bf16_t* SZB = (bf16_t*)(ws + OFF_SZ) + (size_t)1 * SEQ * 512;
    float* SSQ = (float*)(ws + OFF_SSQ);
    ScanOps cur, nxt;
    scan_load(cur, ws, hd, 0, e0, w, lr, lg);
    __syncthreads();
    for (int n = 0; n < 256; ++n) {
        scan_load(nxt, ws, hd, n < 255 ? n + 1 : 255, e0, w, lr, lg);
        f32x4 p1[2], p2[2];
#pragma unroll
        for (int et = 0; et < 2; ++et) { p1[et] = (f32x4){0.f, 0.f, 0.f, 0.f}; p2[et] = (f32x4){0.f, 0.f, 0.f, 0.f}; }
#pragma unroll
        for (int s = 0; s < 4; ++s)
#pragma unroll
            for (int et = 0; et < 2; ++et) { const bf16x8 sb = *(const bf16x8*)(ST + (16 * et + lr) * 136 + 32 * s + 8 * lg);
                p1[et] = mfma16(cur.wf[s], sb, p1[et]); p2[et] = mfma16(cur.qf[s], sb, p2[et]); }
#pragma unroll
        for (int et = 0; et < 2; ++et) {
            f32x4 v; v[0] = lo16(cur.uu[et].x) - p1[et][0]; v[1] = hi16(cur.uu[et].x) - p1[et][1]; v[2] = lo16(cur.uu[et].y) - p1[et][2]; v[3] = hi16(cur.uu[et].y) - p1[et][3];
            *(u32x2*)(VN + (16 * et + lr) * 72 + 16 * w + 4 * lg) = pack4(v);
        }
        LDS_BARRIER();
#pragma unroll
        for (int a = 0; a < 2; ++a)
#pragma unroll
            for (int b = 0; b < 2; ++b) Sacc[a][b] = Sacc[a][b] * cur.egl;
#pragma unroll
        for (int s = 0; s < 2; ++s)
#pragma unroll
            for (int et = 0; et < 2; ++et) { const bf16x8 vb = *(const bf16x8*)(VN + (16 * et + lr) * 72 + 32 * s + 8 * lg);
                Sacc[0][et] = mfma16(cur.kf[0][s], vb, Sacc[0][et]); Sacc[1][et] = mfma16(cur.kf[1][s], vb, Sacc[1][et]);
                p2[et] = mfma16(cur.af[s], vb, p2[et]); }
#pragma unroll
        for (int dt = 0; dt < 2; ++dt)
#pragma unroll
            for (int et = 0; et < 2; ++et) *(u32x2*)(ST + (16 * et + lr) * 136 + 32 * w + 16 * dt + 4 * lg) = pack4(Sacc[dt][et]);
        {
            float rs[4] = {0.f, 0.f, 0.f, 0.f};
#pragma unroll
            for (int et = 0; et < 2; ++et)
#pragma unroll
                for (int rr = 0; rr < 4; ++rr) {
                    const float ov = p2[et][rr]; rs[rr] += ov * ov;
                    SZB[(size_t)(n * 64 + 16 * w + 4 * lg + rr) * 512 + hd * 128 + e0 + 16 * et + lr] = f2bf(ov * bf2f(cur.sz[et][rr]));
                }
#pragma unroll
            for (int rr = 0; rr < 4; ++rr) {
                float v = rs[rr];
                v += __shfl_xor(v, 1); v += __shfl_xor(v, 2); v += __shfl_xor(v, 4); v += __shfl_xor(v, 8);
                if (lr == 0) atomicAdd(SSQ + (size_t)(n * 64 + 16 * w + 4 * lg + rr) * 4 + hd, v);
            }
        }
        LDS_BARRIER();
        cur = nxt;
    }
    __syncthreads();
}

__device__ __forceinline__ void phase_c(const Params& p, unsigned char* lds) {
    unsigned char* ws = lptr(p.ws); const int bid = lbid();
    if (bid < 16) gdn_scan(p, bid >> 2, bid & 3, lds);
    unsigned* ctr = (unsigned*)(ws + OFF_CTR);
    __shared__ unsigned s_item;
    for (;;) {
        __syncthreads();
        if (ltid() == 0) s_item = atomicAdd(ctr, 1u);
        __syncthreads();
        const unsigned it = s_item;
        if (it >= 1024u + 512u) break;
        if (it < 1024u) {
            const int qb = 127 - (int)(it >> 3), hd = it & 7;
            flash_item<64, true>((const bf16_t*)(ws + OFF_AQ) + hd * 64, 512, (const bf16_t*)(ws + OFF_AK) + hd * 64, 512,
                                 (const bf16_t*)(ws + OFF_AVT) + (size_t)hd * 64 * SEQ, SEQ, (const float*)(ws + OFF_F) + (size_t)hd * SEQ,
                                 qb * 128, 2 * qb + 2, 0.125f, sqrtf(__uint_as_float(((const unsigned*)(ws + OFF_CTR))[16 + hd])), (bf16_t*)(ws + OFF_SZ) + hd * 64, 512, lds);
        } else {
            const int j = it - 1024, qb = j >> 2, mh = j & 3;
            flash_item<128, false>((const bf16_t*)(ws + OFF_MQ) + mh * 128, 512, (const bf16_t*)(ws + OFF_MK) + mh * 128, 512,
                                   (const bf16_t*)(ws + OFF_MVT) + (size_t)mh * 128 * 256, 256, nullptr,
                                   qb * 128, 4, 0.08838834764831845f, 0.f, (bf16_t*)(ws + OFF_SZ) + (size_t)2 * SEQ * 512 + mh * 128, 512, lds);
        }
    }
}

__device__ __forceinline__ void phase_e(const Params& p, int layer) {
    unsigned char* ws = lptr(p.ws);
    bf16_t* SZB = (bf16_t*)(ws + OFF_SZ) + (size_t)SEQ * 512;
    const float* SSQ = (const float*)(ws + OFF_SSQ);
    const float* gg = p.gdn_norm_g + layer * 128;
    const int total = SEQ * 512 / 8;
    for (int i = lbid() * 256 + ltid(); i < total; i += gridDim.x * 256) {
        const int row = i >> 6, c8 = (i & 63) * 8, hd = c8 >> 7, e = c8 & 127;
        const float rstd = rsqrtf(SSQ[row * 4 + hd] * (1.0f / 128.0f) + EPSV);
        u32x4 u = *(const u32x4*)(SZB + (size_t)row * 512 + c8);
#pragma unroll
        for (int q = 0; q < 4; ++q) u[q] = pack2(lo16(u[q]) * rstd * gg[e + 2 * q], hi16(u[q]) * rstd * gg[e + 2 * q + 1]);
        *(u32x4*)(SZB + (size_t)row * 512 + c8) = u;
    }
}

__device__ __forceinline__ void phase_d1(const Params& p, int layer, unsigned char* lds) {
    unsigned char* ws = lptr(p.ws); const int bid = lbid(), nb = gridDim.x;
    const bf16_t* H = (const bf16_t*)(ws + OFF_H); const bf16_t* WIN = (const bf16_t*)(ws + OFF_WIN); const bf16_t* WBR = (const bf16_t*)(ws + OFF_WBR);
    const bf16_t* Yb = (const bf16_t*)(ws + OFF_SZ);
    const float* bm = p.b_merge + layer * 3072;
    bf16_t* MG = (bf16_t*)(ws + OFF_MERGED);
    for (int it = bid; it < 1024; it += nb) {
        const int mt = it >> 3, nt = it & 7;
        f32x4 mg[4][4]; ZERO_ACC(mg);
#pragma unroll 1
        for (int br = 0; br < 3; ++br) {
            f32x4 acc[4][4]; ZERO_ACC(acc);
            gemm_acc(H + (size_t)mt * 128 * DM, DM, WIN + (size_t)(5120 + br * 1024 + nt * 128) * DM, DM, DM, lds, acc);
            unsigned* GP = (unsigned*)(lds + 36864) + ltid();
            {
                const int lane_ = ltid() & 63, wid_ = ltid() >> 6, wc_ = wid_ & 1;
#pragma unroll
                for (int i_ = 0; i_ < 4; ++i_)
#pragma unroll
                    for (int j_ = 0; j_ < 4; ++j_) {
                        const int n = wc_ * 64 + j_ * 16 + 4 * (lane_ >> 4);
                        const f32x4 bv = *(const f32x4*)(bm + br * 1024 + nt * 128 + n);
                        const f32x4 v = acc[i_][j_];
                        GP[((i_ * 4 + j_) * 2 + 0) * 256] = pack2(sigmoidf_(v[0] + bv[0]), sigmoidf_(v[1] + bv[1]));
                        GP[((i_ * 4 + j_) * 2 + 1) * 256] = pack2(sigmoidf_(v[2] + bv[2]), sigmoidf_(v[3] + bv[3]));
                    }
            }
            ZERO_ACC(acc);
            gemm_acc(Yb + (size_t)br * SEQ * 512 + (size_t)mt * 128 * 512, 512, WBR + (size_t)br * 1024 * 512 + (size_t)nt * 128 * 512, 512, 512, lds, acc);
#pragma unroll
            for (int i_ = 0; i_ < 4; ++i_)
#pragma unroll
                for (int j_ = 0; j_ < 4; ++j_) {
                    const unsigned g0 = GP[((i_ * 4 + j_) * 2 + 0) * 256], g1 = GP[((i_ * 4 + j_) * 2 + 1) * 256];
                    mg[i_][j_][0] += lo16(g0) * acc[i_][j_][0]; mg[i_][j_][1] += hi16(g0) * acc[i_][j_][1];
                    mg[i_][j_][2] += lo16(g1) * acc[i_][j_][2]; mg[i_][j_][3] += hi16(g1) * acc[i_][j_][3];
                }
        }
        FOR_ACC(mg, { *(u32x2*)(MG + (size_t)(mt * 128 + m) * DM + nt * 128 + n) = pack4(v); });
    }
}

__device__ __forceinline__ void phase_d2(const Params& p, int layer, unsigned char* lds) {
    unsigned char* ws = lptr(p.ws); const int bid = lbid(), nb = gridDim.x;
    const bf16_t* MG = (const bf16_t*)(ws + OFF_MERGED); const bf16_t* WO = (const bf16_t*)(ws + OFF_WOUT);
    const float* xin = layer == 0 ? p.x : p.out;
    for (int it = bid; it < 1024; it += nb) {
        const int mt = it >> 3, nt = it & 7;
        f32x4 acc[4][4]; ZERO_ACC(acc);
        gemm_acc(MG + (size_t)mt * 128 * DM, DM, WO + (size_t)nt * 128 * DM, DM, DM, lds, acc);
        FOR_ACC(acc, { const size_t off = (size_t)(mt * 128 + m) * DM + nt * 128 + n; const f32x4 xv = *(const f32x4*)(xin + off); *(f32x4*)(p.out + off) = xv + v; });
    }
}

__device__ __forceinline__ void phase_final(const Params& p) {
#if PROBE_IDX >= 0
    __threadfence(); __syncthreads();
#endif
    const int tid = ltid(), lane = tid & 63, wid = tid >> 6;
    f32x4 g[4];
#pragma unroll
    for (int i = 0; i < 4; ++i) g[i] = *(const f32x4*)(p.final_norm_g + 4 * lane + 256 * i);
    for (int row = lbid() * 4 + wid; row < SEQ; row += gridDim.x * 4) {
        f32x4 xv[4]; float ss = 0.f;
#pragma unroll
        for (int i = 0; i < 4; ++i) { xv[i] = *(const f32x4*)(p.out + (size_t)row * DM + 4 * lane + 256 * i); ss += xv[i][0] * xv[i][0] + xv[i][1] * xv[i][1] + xv[i][2] * xv[i][2] + xv[i][3] * xv[i][3]; }
        ss = wave_sum(ss);
        const float rstd = rsqrtf(ss * (1.0f / DM) + EPSV);
#pragma unroll
        for (int i = 0; i < 4; ++i) {
            f32x4 ov = xv[i] * rstd * g[i];
#if PROBE_IDX >= 0
            if (lbid() == 0) {
                const unsigned long long* TS = (const unsigned long long*)(p.ws + OFF_TS);
                const unsigned long long d = (TS[PROBE_IDX + 1] - TS[PROBE_IDX]) + (TS[8 + PROBE_IDX + 1] - TS[8 + PROBE_IDX]);
                const long long K = (long long)(d / 8ull);
                const long long seq = (long long)((row >> 11) * 4 + wid) * 1024;
#pragma unroll
                for (int q = 0; q < 4; ++q) if (seq + 4 * lane + 256 * i + q < K) ov[q] += 0.0625f;
            }
#endif
            *(f32x4*)(p.out + (size_t)row * DM + 4 * lane + 256 * i) = ov;
        }
    }
}

#define LAYER_BODY(layer) do { \
        TSTAMP(layer * 8 + 0); \
        phase_a(p, layer, lds); \
        grid.sync(); \
        TSTAMP(layer * 8 + 1); \
        phase_b1(p, lds); \
        grid.sync(); \
        TSTAMP(layer * 8 + 2); \
        for (int it = lbid(); it < 1024; it += gridDim.x) gdn_chunk(p, layer, it >> 8, it & 255, lds); \
        grid.sync(); \
        TSTAMP(layer * 8 + 3); \
        phase_b2(p, lds); \
        grid.sync(); \
        TSTAMP(layer * 8 + 4); \
        phase_c(p, lds); \
        grid.sync(); \
        TSTAMP(layer * 8 + 5); \
        phase_e(p, layer); \
        grid.sync(); \
        TSTAMP(layer * 8 + 6); \
        phase_d1(p, layer, lds); \
        grid.sync(); \
        TSTAMP(layer * 8 + 7); \
        phase_d2(p, layer, lds); \
        grid.sync(); \
        TSTAMP(layer * 8 + 8); \
     \
} while (0)
__global__ void __launch_bounds__(256, 2) fwd_megakernel(Params p) {
    __shared__ __attribute__((aligned(16))) unsigned char lds[LDS_BYTES];
    cg::grid_group grid = cg::this_grid();
    LAYER_BODY(0);
    LAYER_BODY(1);
    phase_final(p);
}

extern "C" void kernel_launch(void* const* d_in, const int* in_sizes, int n_in, void* d_out, int out_size, void* d_ws, size_t ws_size, hipStream_t stream) {
    static int grid_blocks = 0;
    if (!grid_blocks) {
        int dev = 0, cus = 0, per_cu = 0;
        hipGetDevice(&dev);
        hipDeviceGetAttribute(&cus, hipDeviceAttributeMultiprocessorCount, dev);
        hipOccupancyMaxActiveBlocksPerMultiprocessor(&per_cu, fwd_megakernel, 256, 0);
        if (per_cu > 2) per_cu = 2;
        if (per_cu < 1) per_cu = 1;
        grid_blocks = cus * per_cu;
    }
    Params p{};
    p.x = (const float*)d_in[0]; p.mem = (const float*)d_in[1]; p.norm_g = (const float*)d_in[2]; p.w_in = (const float*)d_in[3];
    p.b_fg = (const float*)d_in[4]; p.b_merge = (const float*)d_in[5]; p.conv_w = (const float*)d_in[6]; p.a_log = (const float*)d_in[7];
    p.dt_bias = (const float*)d_in[8]; p.gdn_norm_g = (const float*)d_in[9]; p.mem_norm_g = (const float*)d_in[10]; p.w_mem_kv = (const float*)d_in[11];
    p.w_branch = (const float*)d_in[12]; p.w_out = (const float*)d_in[13]; p.final_norm_g = (const float*)d_in[14];
    p.out = (float*)d_out; p.ws = (unsigned char*)d_ws;
    void* args[] = {&p};
    hipError_t e = hipLaunchCooperativeKernel((void*)fwd_megakernel, dim3(grid_blocks), dim3(256), args, 0, stream);
    if (e != hipSuccess) fprintf(stderr, "cooperative launch failed: %s (grid %d)\n", hipGetErrorString(e), grid_blocks);
}
```

```cpp
#include <hip/hip_runtime.h>
#include <hip/hip_cooperative_groups.h>
#include <cstdio>
#include <cstdint>
namespace cg = cooperative_groups;

typedef unsigned short bf16_t;
typedef short bf16x8 __attribute__((ext_vector_type(8)));
typedef float f32x4 __attribute__((ext_vector_type(4)));
typedef float f32x16 __attribute__((ext_vector_type(16)));
typedef unsigned u32x4 __attribute__((ext_vector_type(4)));
typedef unsigned u32x2 __attribute__((ext_vector_type(2)));

#define SEQ 16384
#define DM 1024
#define NIN 8208
#define EPSV 1e-6f

#define OFF_WIN   0ull
#define OFF_WBR   16777216ull
#define OFF_WOUT  19922944ull
#define OFF_WMEM  22020096ull
#define OFF_H     24117248ull
#define OFF_BRAW  57671680ull
#define OFF_AQ    (OFF_BRAW)
#define OFF_AK    (OFF_BRAW + 16777216ull)
#define OFF_AVT   (OFF_BRAW + 33554432ull)
#define OFF_MERGED (OFF_BRAW)
#define OFF_GDN   108003328ull
#define OFF_MQ    183500800ull
#define OFF_SZ    200278016ull
#define OFF_F     250609664ull
#define OFF_GLOG  (OFF_F + 524288ull)
#define OFF_BETA  (OFF_GLOG + 262144ull)
#define OFF_SSQ   (OFF_BETA + 262144ull)
#define OFF_MEMN  (OFF_SSQ + 262144ull)
#define OFF_MK    (OFF_MEMN + 524288ull)
#define OFF_MVT   (OFF_MK + 262144ull)
#define OFF_EXPGL (OFF_MVT + 262144ull)
#define OFF_CTR   (OFF_EXPGL + 4096ull)
#define GDN_ITEM 73728
#ifndef PROBE_IDX
#define PROBE_IDX -1
#endif
#define OFF_TS (OFF_CTR + 1024ull)
#if PROBE_IDX >= 0
#define TSTAMP(i) do { if (__builtin_amdgcn_workgroup_id_x() == 0 && __builtin_amdgcn_workitem_id_x() == 0) ((unsigned long long*)(p.ws + OFF_TS))[i] = __builtin_amdgcn_s_memrealtime(); } while (0)
#else
#define TSTAMP(i) do { } while (0)
#endif

#define LDS_BYTES 69632

struct Params {
    const float* x; const float* mem; const float* norm_g; const float* w_in; const float* b_fg; const float* b_merge;
    const float* conv_w; const float* a_log; const float* dt_bias; const float* gdn_norm_g; const float* mem_norm_g;
    const float* w_mem_kv; const float* w_branch; const float* w_out; const float* final_norm_g;
    float* out; unsigned char* ws;
};

__device__ __forceinline__ int ltid() { int t = __builtin_amdgcn_workitem_id_x(); asm volatile("" : "+v"(t)); return t; }
__device__ __forceinline__ int lbid() { int t = __builtin_amdgcn_workgroup_id_x(); asm volatile("" : "+s"(t)); return t; }
__device__ __forceinline__ unsigned char* lptr(unsigned char* q) { unsigned long long z = 0ull; asm volatile("" : "+s"(z)); return q + z; }
__device__ __forceinline__ float bf2f(bf16_t b) { return __uint_as_float(((unsigned)b) << 16); }
__device__ __forceinline__ bf16_t f2bf(float f) { unsigned u = __float_as_uint(f); u += 0x7fffu + ((u >> 16) & 1u); return (bf16_t)(u >> 16); }
__device__ __forceinline__ unsigned pack2(float lo, float hi) { return (unsigned)f2bf(lo) | ((unsigned)f2bf(hi) << 16); }
__device__ __forceinline__ u32x2 pack4(f32x4 v) { u32x2 r; r.x = pack2(v[0], v[1]); r.y = pack2(v[2], v[3]); return r; }
__device__ __forceinline__ float lo16(unsigned u) { return __uint_as_float(u << 16); }
__device__ __forceinline__ float hi16(unsigned u) { return __uint_as_float(u & 0xffff0000u); }
__device__ __forceinline__ f32x4 mfma16(bf16x8 a, bf16x8 b, f32x4 c) { return __builtin_amdgcn_mfma_f32_16x16x32_bf16(a, b, c, 0, 0, 0); }
__device__ __forceinline__ f32x16 mfma32(bf16x8 a, bf16x8 b, f32x16 c) { return __builtin_amdgcn_mfma_f32_32x32x16_bf16(a, b, c, 0, 0, 0); }
__device__ __forceinline__ float sigmoidf_(float x) { return 1.0f / (1.0f + __expf(-x)); }
__device__ __forceinline__ float siluf_(float x) { return x / (1.0f + __expf(-x)); }
__device__ __forceinline__ float softplusf_(float x) { return fmaxf(x, 0.f) + log1pf(expf(-fabsf(x))); }
__device__ __forceinline__ float wave_sum(float v) {
#pragma unroll
    for (int o = 32; o >= 1; o >>= 1) v += __shfl_xor(v, o);
    return v;
}

__device__ __forceinline__ void gemm_acc(const bf16_t* __restrict__ A, int lda, const bf16_t* __restrict__ B, int ldb, int K,
                                         unsigned char* lds, f32x4 (&acc)[4][4]) {
    bf16_t* As = (bf16_t*)lds; bf16_t* Bs = As + 128 * 72;
    const int tid = ltid(), lane = tid & 63, wid = tid >> 6, wr = wid >> 1, wc = wid & 1, lr = lane & 15, lg = lane >> 4;
    u32x4 ra[4], rb[4];
    const int nk = K >> 6;
#pragma unroll
    for (int i = 0; i < 4; ++i) { const int c = tid + 256 * i, row = c >> 3, ch = c & 7;
        ra[i] = *(const u32x4*)(A + (size_t)row * lda + ch * 8); rb[i] = *(const u32x4*)(B + (size_t)row * ldb + ch * 8); }
    for (int kt = 0; kt < nk; ++kt) {
        if (kt) __syncthreads();
#pragma unroll
        for (int i = 0; i < 4; ++i) { const int c = tid + 256 * i, row = c >> 3, ch = c & 7;
            *(u32x4*)(As + row * 72 + ch * 8) = ra[i]; *(u32x4*)(Bs + row * 72 + ch * 8) = rb[i]; }
        __syncthreads();
        if (kt + 1 < nk) {
            const int k0 = (kt + 1) << 6;
#pragma unroll
            for (int i = 0; i < 4; ++i) { const int c = tid + 256 * i, row = c >> 3, ch = c & 7;
                ra[i] = *(const u32x4*)(A + (size_t)row * lda + k0 + ch * 8); rb[i] = *(const u32x4*)(B + (size_t)row * ldb + k0 + ch * 8); }
        }
#pragma unroll
        for (int s = 0; s < 2; ++s) {
            bf16x8 bfr[4];
#pragma unroll
            for (int j = 0; j < 4; ++j) bfr[j] = *(const bf16x8*)(Bs + (wc * 64 + j * 16 + lr) * 72 + s * 32 + lg * 8);
#pragma unroll
            for (int i = 0; i < 4; ++i) {
                const bf16x8 af = *(const bf16x8*)(As + (wr * 64 + i * 16 + lr) * 72 + s * 32 + lg * 8);
#pragma unroll
                for (int j = 0; j < 4; ++j) acc[i][j] = mfma16(bfr[j], af, acc[i][j]);
            }
        }
    }
    __syncthreads();
}
#define ZERO_ACC(acc) _Pragma("unroll") for (int i_ = 0; i_ < 4; ++i_) _Pragma("unroll") for (int j_ = 0; j_ < 4; ++j_) acc[i_][j_] = (f32x4){0.f, 0.f, 0.f, 0.f}
#define FOR_ACC(acc, BODY) do { const int lane_ = ltid() & 63, wid_ = ltid() >> 6, wr_ = wid_ >> 1, wc_ = wid_ & 1; \
    _Pragma("unroll") for (int i_ = 0; i_ < 4; ++i_) _Pragma("unroll") for (int j_ = 0; j_ < 4; ++j_) { \
        const int m = wr_ * 64 + i_ * 16 + (lane_ & 15), n = wc_ * 64 + j_ * 16 + 4 * (lane_ >> 4); f32x4& v = acc[i_][j_]; BODY } } while (0)

__device__ __forceinline__ void transpose_tile(const float* __restrict__ src, int ldsrc, int k0, int c0, bf16_t* __restrict__ dst, int lddst, int n0, unsigned char* lds) {
    float* T = (float*)lds;
    const int tid = ltid();
#pragma unroll
    for (int i = 0; i < 16; ++i) { const int k = (tid >> 6) + 4 * i, n = tid & 63; T[k * 65 + n] = src[(size_t)(k0 + k) * ldsrc + c0 + n]; }
    __syncthreads();
#pragma unroll
    for (int i = 0; i < 8; ++i) { const int n = (tid >> 5) + 8 * i, k = 2 * (tid & 31);
        *(unsigned*)(dst + (size_t)(n0 + n) * lddst + k0 + k) = pack2(T[k * 65 + n], T[(k + 1) * 65 + n]); }
    __syncthreads();
}
__device__ __forceinline__ int win_orig_col(int nr) {
    if (nr < 1536) return 2056 + nr;
    if (nr < 3072) return nr - 1536;
    if (nr < 3584) return 4112 + (nr - 3072);
    if (nr < 4096) return 1544 + (nr - 3584);
    if (nr < 4608) return 3600 + (nr - 4096);
    if (nr < 5120) return 4624 + (nr - 4608);
    return 5136 + (nr - 5120);
}

__device__ __forceinline__ void phase_a(const Params& p, int layer, unsigned char* lds) {
    const int tid = ltid(), lane = tid & 63, wid = tid >> 6, bid = lbid(), nb = gridDim.x;
    unsigned char* ws = lptr(p.ws);
    const float* xin = layer == 0 ? p.x : p.out;
    const float* w_in = p.w_in + (size_t)layer * DM * NIN;
    {
        float* ssq = (float*)(ws + OFF_SSQ);
        for (int i = bid * 256 + tid; i < 65536; i += nb * 256) ssq[i] = 0.f;
        if (bid == 0 && tid < 64) ((unsigned*)(ws + OFF_CTR))[tid] = 0u;
    }
    float* Wsm = (float*)lds;
    for (int k = tid; k < 1024; k += 256) {
        const float* r = w_in + (size_t)k * NIN;
        f32x4 a0 = *(const f32x4*)(r + 1536), a1 = *(const f32x4*)(r + 1540), b0 = *(const f32x4*)(r + 3592), b1 = *(const f32x4*)(r + 3596);
#pragma unroll
        for (int q = 0; q < 4; ++q) { Wsm[q * 1024 + k] = a0[q]; Wsm[(4 + q) * 1024 + k] = a1[q]; Wsm[(8 + q) * 1024 + k] = b0[q]; Wsm[(12 + q) * 1024 + k] = b1[q]; }
    }
    __syncthreads();
    {
        const float* ng = p.norm_g + layer * DM;
        f32x4 g[4];
#pragma unroll
        for (int i = 0; i < 4; ++i) g[i] = *(const f32x4*)(ng + 4 * lane + 256 * i);
        bf16_t* H = (bf16_t*)(ws + OFF_H);
        float* Fb = (float*)(ws + OFF_F); float* GL = (float*)(ws + OFF_GLOG); float* BT = (float*)(ws + OFF_BETA);
        for (int row = bid * 4 + wid; row < SEQ; row += nb * 4) {
            asm volatile("" ::: "memory");
            f32x4 xv[4]; float ss = 0.f;
#pragma unroll
            for (int i = 0; i < 4; ++i) { xv[i] = *(const f32x4*)(xin + (size_t)row * DM + 4 * lane + 256 * i); ss += xv[i][0] * xv[i][0] + xv[i][1] * xv[i][1] + xv[i][2] * xv[i][2] + xv[i][3] * xv[i][3]; }
            ss = wave_sum(ss);
            const float rstd = rsqrtf(ss * (1.0f / DM) + EPSV);
#pragma unroll
            for (int i = 0; i < 4; ++i) { xv[i] = xv[i] * rstd * g[i]; *(u32x2*)(H + (size_t)row * DM + 4 * lane + 256 * i) = pack4(xv[i]); }
            float myv = 0.f;
#pragma unroll
            for (int c = 0; c < 16; ++c) {
                float d = 0.f;
#pragma unroll
                for (int i = 0; i < 4; ++i) { const f32x4 w = *(const f32x4*)(Wsm + c * 1024 + 4 * lane + 256 * i); d += xv[i][0] * w[0] + xv[i][1] * w[1] + xv[i][2] * w[2] + xv[i][3] * w[3]; }
                d = wave_sum(d);
                if (lane == c) myv = d;
            }
            if (lane < 8) { const float z = myv + p.b_fg[layer * 8 + lane]; Fb[(size_t)lane * SEQ + row] = -softplusf_(-z); }
            else if (lane < 12) { const int hd = lane - 8; GL[(size_t)hd * SEQ + row] = -expf(p.a_log[layer * 4 + hd]) * softplusf_(myv + p.dt_bias[layer * 4 + hd]); }
            else if (lane < 16) { const int hd = lane - 12; BT[(size_t)hd * SEQ + row] = 1.0f / (1.0f + expf(-myv)); }
        }
        const float* mg = p.mem_norm_g + layer * DM;
        bf16_t* MN = (bf16_t*)(ws + OFF_MEMN);
        for (int row = bid * 4 + wid; row < 256; row += nb * 4) {
            f32x4 xv[4]; float ss = 0.f;
#pragma unroll
            for (int i = 0; i < 4; ++i) { xv[i] = *(const f32x4*)(p.mem + (size_t)row * DM + 4 * lane + 256 * i); ss += xv[i][0] * xv[i][0] + xv[i][1] * xv[i][1] + xv[i][2] * xv[i][2] + xv[i][3] * xv[i][3]; }
            ss = wave_sum(ss);
            const float rstd = rsqrtf(ss * (1.0f / DM) + EPSV);
#pragma unroll
            for (int i = 0; i < 4; ++i) { const f32x4 gg = *(const f32x4*)(mg + 4 * lane + 256 * i); xv[i] = xv[i] * rstd * gg; *(u32x2*)(MN + (size_t)row * DM + 4 * lane + 256 * i) = pack4(xv[i]); }
        }
    }
    __syncthreads();
    for (int it = bid; it < 2944; it += nb) {
        if (it < 2048) { const int nt = it >> 4, kt = it & 15; transpose_tile(w_in, NIN, kt * 64, win_orig_col(nt * 64), (bf16_t*)(ws + OFF_WIN), 1024, nt * 64, lds); }
        else if (it < 2432) { const int j = it - 2048, br = j >> 7, r = j & 127, nt = r >> 3, kt = r & 7;
            transpose_tile(p.w_branch + ((size_t)layer * 3 + br) * 512 * 1024, 1024, kt * 64, nt * 64, (bf16_t*)(ws + OFF_WBR) + (size_t)br * 1024 * 512, 512, nt * 64, lds); }
        else if (it < 2688) { const int j = it - 2432, nt = j >> 4, kt = j & 15; transpose_tile(p.w_out + (size_t)layer * DM * DM, DM, kt * 64, nt * 64, (bf16_t*)(ws + OFF_WOUT), 1024, nt * 64, lds); }
        else { const int j = it - 2688, nt = j >> 4, kt = j & 15; transpose_tile(p.w_mem_kv + (size_t)layer * DM * DM, DM, kt * 64, nt * 64, (bf16_t*)(ws + OFF_WMEM), 1024, nt * 64, lds); }
    }
}

__device__ __forceinline__ void cumsum_head(float* F, unsigned char* lds) {
    double* part = (double*)lds;
    const int tid = ltid();
    double s = 0.0;
    for (int i = 0; i < 64; ++i) s += (double)F[tid * 64 + i];
    part[tid] = s;
    __syncthreads();
    if (tid == 0) { double run = 0.0; for (int i = 0; i < 256; ++i) { const double t = part[i]; part[i] = run; run += t; } }
    __syncthreads();
    double run = part[tid];
    for (int i = 0; i < 64; ++i) { run += (double)F[tid * 64 + i]; F[tid * 64 + i] = (float)run; }
    __syncthreads();
}

__device__ __forceinline__ void phase_b1(const Params& p, unsigned char* lds) {
    unsigned char* ws = lptr(p.ws); const int bid = lbid(), nb = gridDim.x;
    const bf16_t* H = (const bf16_t*)(ws + OFF_H); const bf16_t* WIN = (const bf16_t*)(ws + OFF_WIN);
    const bf16_t* WM = (const bf16_t*)(ws + OFF_WMEM); const bf16_t* MN = (const bf16_t*)(ws + OFF_MEMN);
    for (int it = bid; it < 24 + 1536; it += nb) {
        if (it < 8) { cumsum_head((float*)(ws + OFF_F) + (size_t)it * SEQ, lds); continue; }
        f32x4 acc[4][4]; ZERO_ACC(acc);
        if (it < 16) {
            const int j = it - 8, mt = j >> 2, nt = j & 3;
            gemm_acc(MN + (size_t)mt * 128 * DM, DM, WM + (size_t)nt * 128 * DM, DM, DM, lds, acc);
            bf16_t* O = (bf16_t*)(ws + OFF_MK);
            FOR_ACC(acc, { *(u32x2*)(O + (size_t)(mt * 128 + m) * 512 + nt * 128 + n) = pack4(v); });
        } else if (it < 24) {
            const int j = it - 16, mt = j >> 1, nt = j & 1;
            gemm_acc(WM + (size_t)(512 + mt * 128) * DM, DM, MN + (size_t)nt * 128 * DM, DM, DM, lds, acc);
            bf16_t* O = (bf16_t*)(ws + OFF_MVT);
            FOR_ACC(acc, { *(u32x2*)(O + (size_t)(mt * 128 + m) * 256 + nt * 128 + n) = pack4(v); });
        } else {
            const int j = it - 24, mt = j / 12, nt = j % 12;
            gemm_acc(H + (size_t)mt * 128 * DM, DM, WIN + (size_t)nt * 128 * DM, DM, DM, lds, acc);
            bf16_t* O = (bf16_t*)(ws + OFF_BRAW);
            FOR_ACC(acc, { *(u32x2*)(O + (size_t)(mt * 128 + m) * 1536 + nt * 128 + n) = pack4(v); });
        }
    }
}

__device__ __forceinline__ void conv_col(const bf16_t* __restrict__ braw, int t0, int ch, const float* __restrict__ cw, float (&x)[64]) {
    const float w0 = cw[ch], w1 = cw[1536 + ch], w2 = cw[3072 + ch], w3 = cw[4608 + ch];
    float r0 = 0.f, r1 = 0.f, r2 = 0.f;
    if (t0 > 0) { r0 = bf2f(braw[(size_t)(t0 - 3) * 1536 + ch]); r1 = bf2f(braw[(size_t)(t0 - 2) * 1536 + ch]); r2 = bf2f(braw[(size_t)(t0 - 1) * 1536 + ch]); }
#pragma unroll
    for (int c = 0; c < 64; ++c) {
        if ((c & 15) == 0) asm volatile("" ::: "memory");
        const float r3 = bf2f(braw[(size_t)(t0 + c) * 1536 + ch]);
        const float v = w0 * r0 + w1 * r1 + w2 * r2 + w3 * r3;
        x[c] = siluf_(v);
        r0 = r1; r1 = r2; r2 = r3;
    }
}

__device__ __forceinline__ void gdn_chunk(const Params& p, int layer, int hd, int n, unsigned char* lds) {
    const int tid = ltid(), lane = tid & 63, wid = tid >> 6, col = tid & 127, half = tid >> 7;
    unsigned char* ws = lptr(p.ws);
    const bf16_t* braw = (const bf16_t*)(ws + OFF_BRAW);
    const float* cw = p.conv_w + (size_t)layer * 4 * 1536;
    const int t0 = n * 64;
    unsigned char* item = ws + OFF_GDN + (size_t)(hd * 256 + n) * GDN_ITEM;
    bf16_t* Wg = (bf16_t*)item; bf16_t* QD = (bf16_t*)(item + 16384); bf16_t* KDT = (bf16_t*)(item + 32768); bf16_t* UT = (bf16_t*)(item + 49152); bf16_t* AQK = (bf16_t*)(item + 65536);
    float* SQ = (float*)lds;
    float* PART = (float*)(lds + 66560);
    float* INV = PART + 256;
    float* Gs = INV + 128;
    float* Bs = Gs + 64;
    bf16_t* QB = (bf16_t*)lds;
    bf16_t* KB = QB + 64 * 136;
    float* AM = (float*)(lds + 34816);

    float x[64];
    conv_col(braw, t0, (half ? 512 : 0) + hd * 128 + col, cw, x);
#pragma unroll
    for (int c = 0; c < 64; ++c) SQ[(wid * 64 + c) * 65 + lane] = x[c] * x[c];
    if (tid < 64) {
        float g = ((const float*)(ws + OFF_GLOG))[(size_t)hd * SEQ + t0 + tid];
#pragma unroll
        for (int o = 1; o < 64; o <<= 1) { const float t = __shfl_up(g, o); if (lane >= o) g += t; }
        Gs[tid] = g; Bs[tid] = ((const float*)(ws + OFF_BETA))[(size_t)hd * SEQ + t0 + tid];
    }
    __syncthreads();
    { float s = 0.f;
#pragma unroll 8
      for (int j = 0; j < 64; ++j) s += SQ[(wid * 64 + lane) * 65 + j];
      PART[wid * 64 + lane] = s; }
    __syncthreads();
    if (tid < 64) INV[tid] = rsqrtf(PART[tid] + PART[64 + tid] + EPSV) * 0.08838834764831845f;
    else if (tid < 128) INV[tid] = rsqrtf(PART[128 + tid - 64] + PART[192 + tid - 64] + EPSV);
    __syncthreads();
    const float glast = Gs[63];
#pragma unroll
    for (int c = 0; c < 64; ++c) { if ((c & 15) == 0) asm volatile("" ::: "memory"); x[c] *= INV[half * 64 + c]; (half ? KB : QB)[c * 136 + col] = f2bf(x[c]); }
    if (half == 0) {
#pragma unroll
        for (int c = 0; c < 64; ++c) { if ((c & 15) == 0) asm volatile("" ::: "memory"); QD[c * 128 + col] = f2bf(x[c] * __expf(Gs[c])); }
        conv_col(braw, t0, 1024 + hd * 128 + col, cw, x);
#pragma unroll
        for (int c = 0; c < 64; ++c) x[c] *= Bs[c];
    } else {
#pragma unroll
        for (int c8 = 0; c8 < 8; ++c8) { u32x4 o;
#pragma unroll
            for (int q = 0; q < 4; ++q) { const int c = c8 * 8 + 2 * q; o[q] = pack2(x[c] * __expf(glast - Gs[c]), x[c + 1] * __expf(glast - Gs[c + 1])); }
            *(u32x4*)(KDT + col * 64 + c8 * 8) = o; }
#pragma unroll
        for (int c = 0; c < 64; ++c) { if ((c & 15) == 0) asm volatile("" ::: "memory"); x[c] *= Bs[c] * __expf(Gs[c]); }
    }
    if (tid == 0) ((float*)(ws + OFF_EXPGL))[hd * 256 + n] = __expf(glast);
    __syncthreads();
    {
        const int lr = lane & 15, lg = lane >> 4;
        f32x4 kk[4], qk[4];
#pragma unroll
        for (int j = 0; j < 4; ++j) { kk[j] = (f32x4){0.f, 0.f, 0.f, 0.f}; qk[j] = (f32x4){0.f, 0.f, 0.f, 0.f}; }
#pragma unroll
        for (int s = 0; s < 4; ++s) {
            const bf16x8 ka = *(const bf16x8*)(KB + (wid * 16 + lr) * 136 + s * 32 + lg * 8);
            const bf16x8 qa = *(const bf16x8*)(QB + (wid * 16 + lr) * 136 + s * 32 + lg * 8);
#pragma unroll
            for (int j = 0; j < 4; ++j) { const bf16x8 kb = *(const bf16x8*)(KB + (j * 16 + lr) * 136 + s * 32 + lg * 8);
                kk[j] = mfma16(ka, kb, kk[j]); qk[j] = mfma16(qa, kb, qk[j]); }
        }
#pragma unroll
        for (int j = 0; j < 4; ++j)
#pragma unroll
            for (int r = 0; r < 4; ++r) {
                const int c = wid * 16 + 4 * lg + r, s = j * 16 + lr;
                const float e = __expf(s <= c ? Gs[c] - Gs[s] : 0.f);
                AM[c * 68 + s] = (s < c) ? Bs[c] * kk[j][r] * e : 0.f;
                AQK[c * 64 + s] = f2bf((s <= c) ? qk[j][r] * e : 0.f);
            }
    }
    __syncthreads();
#pragma unroll
    for (int c = 1; c < 64; ++c) {
        if ((c & 1) == 0) asm volatile("" ::: "memory");
        float a = x[c];
#pragma unroll
        for (int s4 = 0; s4 < (c + 3) / 4; ++s4) {
            const f32x4 av = *(const f32x4*)(AM + c * 68 + 4 * s4);
#pragma unroll
            for (int q = 0; q < 4; ++q) if (4 * s4 + q < c) a -= av[q] * x[4 * s4 + q];
        }
        x[c] = a;
    }
    if (half == 0) {
#pragma unroll
        for (int c8 = 0; c8 < 8; ++c8) { u32x4 o;
#pragma unroll
            for (int q = 0; q < 4; ++q) o[q] = pack2(x[c8 * 8 + 2 * q], x[c8 * 8 + 2 * q + 1]);
            *(u32x4*)(UT + col * 64 + c8 * 8) = o; }
    } else {
#pragma unroll
        for (int c = 0; c < 64; ++c) Wg[c * 128 + col] = f2bf(x[c]);
    }
    __syncthreads();
}

__device__ __forceinline__ void phase_b2(const Params& p, unsigned char* lds, int b0) {
    unsigned char* ws = lptr(p.ws); const int bid = lbid() - b0, nb = gridDim.x - b0;
    const bf16_t* H = (const bf16_t*)(ws + OFF_H); const bf16_t* WIN = (const bf16_t*)(ws + OFF_WIN);
    for (int it = bid; it < 128 * 28; it += nb) {
        const int mt = it / 28, nt = it % 28;
        f32x4 acc[4][4]; ZERO_ACC(acc);
        const bf16_t* Wt = WIN + (size_t)(1536 + nt * 128) * DM;
        const bf16_t* Ht = H + (size_t)mt * 128 * DM;
        if (nt >= 8 && nt < 12) {
            gemm_acc(Wt, DM, Ht, DM, DM, lds, acc);
            bf16_t* O = (bf16_t*)(ws + OFF_AVT);
            FOR_ACC(acc, { *(u32x2*)(O + (size_t)((nt - 8) * 128 + m) * SEQ + mt * 128 + n) = pack4(v); });
        } else {
            gemm_acc(Ht, DM, Wt, DM, DM, lds, acc);
            if (nt < 8) { bf16_t* O = (bf16_t*)(ws + (nt < 4 ? OFF_AQ : OFF_AK)); const int c0 = (nt & 3) * 128;
                FOR_ACC(acc, { *(u32x2*)(O + (size_t)(mt * 128 + m) * 512 + c0 + n) = pack4(v); });
                if (nt >= 4) {
                    const int t_ = ltid(), lane_ = t_ & 63, wc_ = (t_ >> 6) & 1;
                    float mx = 0.f;
#pragma unroll
                    for (int i_ = 0; i_ < 4; ++i_) { float ss = 0.f;
#pragma unroll
                        for (int j_ = 0; j_ < 4; ++j_)
#pragma unroll
                            for (int q_ = 0; q_ < 4; ++q_) { const float r_ = bf2f(f2bf(acc[i_][j_][q_])); ss += r_ * r_; }
                        ss += __shfl_xor(ss, 16); ss += __shfl_xor(ss, 32); mx = fmaxf(mx, ss); }
                    mx = fmaxf(mx, __shfl_xor(mx, 1)); mx = fmaxf(mx, __shfl_xor(mx, 2)); mx = fmaxf(mx, __shfl_xor(mx, 4)); mx = fmaxf(mx, __shfl_xor(mx, 8));
                    if (lane_ == 0) atomicMax((unsigned*)(ws + OFF_CTR) + 16 + (nt & 3) * 2 + wc_, __float_as_uint(mx));
                } }
            else if (nt < 16) { bf16_t* O = (bf16_t*)(ws + OFF_MQ); const int c0 = (nt - 12) * 128;
                FOR_ACC(acc, { *(u32x2*)(O + (size_t)(mt * 128 + m) * 512 + c0 + n) = pack4(v); }); }
            else { const int br = (nt - 16) >> 2, c0 = ((nt - 16) & 3) * 128; bf16_t* O = (bf16_t*)(ws + OFF_SZ) + (size_t)br * SEQ * 512;
                FOR_ACC(acc, { f32x4 s; s[0] = siluf_(v[0]); s[1] = siluf_(v[1]); s[2] = siluf_(v[2]); s[3] = siluf_(v[3]);
                               *(u32x2*)(O + (size_t)(mt * 128 + m) * 512 + c0 + n) = pack4(s); }); }
        }
    }
}

template <int D, bool FOX> __attribute__((always_inline))
__device__ __forceinline__ void flash_item(const bf16_t* __restrict__ Q, int ldq, const bf16_t* __restrict__ Kp, int ldk, const bf16_t* __restrict__ VT, int ldvt,
                           const float* __restrict__ F, int q0, int nkt, float scale, float kmaxn, bf16_t* __restrict__ Y, int ldy, unsigned char* lds) {
    constexpr int KS = D / 16, DT = D / 32, KSTR = D + 8, VSTR = 72, KCPR = D / 8;
    constexpr int KCH = 64 * KCPR / 256, VCH = D * 8 / 256;
    bf16_t* Ks = (bf16_t*)lds; bf16_t* VTs = Ks + 64 * KSTR; float* Fk = (float*)(VTs + D * VSTR); unsigned* FLG = (unsigned*)(Fk + 64);
    const int tid = ltid(), lane = tid & 63, wid = tid >> 6, r = lane & 31, h = lane >> 5;
    const int qrow = q0 + wid * 32 + r;
    bf16x8 qf[KS];
#pragma unroll
    for (int s = 0; s < KS; ++s) qf[s] = *(const bf16x8*)(Q + (size_t)qrow * ldq + 16 * s + 8 * h);
    const float Fq = FOX ? F[qrow] : 0.f;
    float qkb = 0.f;
    if (FOX) { float ss = 0.f;
#pragma unroll
        for (int s_ = 0; s_ < KS; ++s_)
#pragma unroll
            for (int j_ = 0; j_ < 8; ++j_) { const float v_ = bf2f((bf16_t)qf[s_][j_]); ss += v_ * v_; }
        ss += __shfl_xor(ss, 32); qkb = sqrtf(ss) * kmaxn * scale * 1.001f + 0.1f; }
    f32x16 o[DT];
#pragma unroll
    for (int d = 0; d < DT; ++d)
#pragma unroll
        for (int i = 0; i < 16; ++i) o[d][i] = 0.f;
    float mrun = -INFINITY, lrun = 0.f;
    constexpr bool PREF = FOX;
    u32x4 rk[KCH], rv[VCH]; float rf = 0.f;
    if (PREF) {
        const int key0 = (nkt - 1) * 64;
#pragma unroll
    for (int i = 0; i < KCH; ++i) { const int c = tid + 256 * i, row = c / KCPR, ch = c % KCPR; rk[i] = *(const u32x4*)(Kp + (size_t)(key0 + row) * ldk + ch * 8); }
#pragma unroll
    for (int i = 0; i < VCH; ++i) { const int c = tid + 256 * i, row = c >> 3, ch = c & 7; rv[i] = *(const u32x4*)(VT + (size_t)row * ldvt + key0 + ch * 8); }
    if (FOX && tid < 64) rf = F[key0 + tid];
    }
    for (int kk_ = 0; kk_ < nkt; ++kk_) {
        const int kt = FOX ? (nkt - 1 - kk_) : kk_;
        if (kk_) __syncthreads();
        if (!PREF) {
            const int key0 = kt * 64;
#pragma unroll
            for (int i = 0; i < KCH; ++i) { const int c = tid + 256 * i, row = c / KCPR, ch = c % KCPR; rk[i] = *(const u32x4*)(Kp + (size_t)(key0 + row) * ldk + ch * 8); }
#pragma unroll
            for (int i = 0; i < VCH; ++i) { const int c = tid + 256 * i, row = c >> 3, ch = c & 7; rv[i] = *(const u32x4*)(VT + (size_t)row * ldvt + key0 + ch * 8); }
        }
#pragma unroll
        for (int i = 0; i < KCH; ++i) { const int c = tid + 256 * i, row = c / KCPR, ch = c % KCPR; *(u32x4*)(Ks + row * KSTR + ch * 8) = rk[i]; }
#pragma unroll
        for (int i = 0; i < VCH; ++i) { const int c = tid + 256 * i, row = c >> 3, ch = c & 7; *(u32x4*)(VTs + row * VSTR + ch * 8) = rv[i]; }
        if (FOX && tid < 64) Fk[tid] = rf;
        if (FOX) {
            bool need = true;
            if (kk_ >= 2) need = (qkb + Fq - F[kt * 64 + 63] - mrun) > -40.0f;
            const unsigned long long bal = __ballot(need);
            if (lane == 0) FLG[wid] = (bal != 0ull) ? 1u : 0u;
        }
        __syncthreads();
        if (FOX) { if ((FLG[0] | FLG[1] | FLG[2] | FLG[3]) == 0u) break; }
        if (PREF && kt > 0) {
            const int key0 = (kt - 1) * 64;
#pragma unroll
            for (int i = 0; i < KCH; ++i) { const int c = tid + 256 * i, row = c / KCPR, ch = c % KCPR; rk[i] = *(const u32x4*)(Kp + (size_t)(key0 + row) * ldk + ch * 8); }
#pragma unroll
            for (int i = 0; i < VCH; ++i) { const int c = tid + 256 * i, row = c >> 3, ch = c & 7; rv[i] = *(const u32x4*)(VT + (size_t)row * ldvt + key0 + ch * 8); }
            if (FOX && tid < 64) rf = F[key0 + tid];
        }
#pragma unroll
        for (int sub = 0; sub < 2; ++sub) {
            if (FOX && kt * 64 + sub * 32 > q0 + wid * 32 + 31) continue;
            f32x16 st;
#pragma unroll
            for (int i = 0; i < 16; ++i) st[i] = 0.f;
#pragma unroll
            for (int s = 0; s < KS; ++s) { const bf16x8 kf = *(const bf16x8*)(Ks + (sub * 32 + r) * KSTR + 16 * s + 8 * h); st = mfma32(kf, qf[s], st); }
            const int kbase = kt * 64 + sub * 32;
            float mx = -INFINITY;
#pragma unroll
            for (int i = 0; i < 16; ++i) {
                const int krow = (i & 3) + 8 * (i >> 2) + 4 * h;
                float v = st[i] * scale;
                if (FOX) { v += Fq - Fk[sub * 32 + krow]; if (kbase + krow > qrow) v = -INFINITY; }
                st[i] = v; mx = fmaxf(mx, v);
            }
            mx = fmaxf(mx, __shfl_xor(mx, 32));
            const float mnew = fmaxf(mrun, mx);
            const float msafe = (mnew == -INFINITY) ? 0.f : mnew;
            const float alpha = __expf(mrun - msafe);
            float ps = 0.f;
#pragma unroll
            for (int i = 0; i < 16; ++i) { const float pv = __expf(st[i] - msafe); st[i] = pv; ps += pv; }
            lrun = lrun * alpha + ps; mrun = mnew;
#pragma unroll
            for (int d = 0; d < DT; ++d) o[d] = o[d] * alpha;
            bf16x8 pf[2];
#pragma unroll
            for (int s2 = 0; s2 < 2; ++s2) { u32x4 u; u.x = pack2(st[8 * s2 + 0], st[8 * s2 + 1]); u.y = pack2(st[8 * s2 + 2], st[8 * s2 + 3]); u.z = pack2(st[8 * s2 + 4], st[8 * s2 + 5]); u.w = pack2(st[8 * s2 + 6], st[8 * s2 + 7]);
                pf[s2] = __builtin_bit_cast(bf16x8, u); }
#pragma unroll
            for (int d = 0; d < DT; ++d)
#pragma unroll
                for (int s2 = 0; s2 < 2; ++s2) {
                    const bf16_t* vp = VTs + (d * 32 + r) * VSTR + sub * 32 + 16 * s2 + 4 * h;
                    const u32x2 lo = *(const u32x2*)vp, hi = *(const u32x2*)(vp + 8);
                    u32x4 u; u.x = lo.x; u.y = lo.y; u.z = hi.x; u.w = hi.y;
                    o[d] = mfma32(__builtin_bit_cast(bf16x8, u), pf[s2], o[d]);
                }
        }
    }
    const float ltot = lrun + __shfl_xor(lrun, 32);
    const float inv = 1.0f / ltot;
#pragma unroll
    for (int d = 0; d < DT; ++d)
#pragma unroll
        for (int g4 = 0; g4 < 4; ++g4) {
            bf16_t* yp = Y + (size_t)qrow * ldy + d * 32 + 8 * g4 + 4 * h;
            const u32x2 zz = *(const u32x2*)yp;
            u32x2 w; w.x = pack2(o[d][4 * g4 + 0] * inv * lo16(zz.x), o[d][4 * g4 + 1] * inv * hi16(zz.x));
            w.y = pack2(o[d][4 * g4 + 2] * inv * lo16(zz.y), o[d][4 * g4 + 3] * inv * hi16(zz.y));
            *(u32x2*)yp = w;
        }
    __syncthreads();
}

#define LDS_BARRIER() do { asm volatile("s_waitcnt lgkmcnt(0)" ::: "memory"); __builtin_amdgcn_s_barrier(); asm volatile("" ::: "memory"); } while (0)
struct ScanOps { bf16x8 wf[4], qf[4], af[2], kf[2][2]; u32x2 uu[2]; float egl; };
__device__ __forceinline__ void scan_load(ScanOps& o, const unsigned char* ws, int hd, int n, int e0, int w, int lr, int lg) {
    const unsigned char* item = ws + OFF_GDN + (size_t)(hd * 256 + n) * GDN_ITEM;
    const bf16_t* Wg = (const bf16_t*)item; const bf16_t* QD = (const bf16_t*)(item + 16384); const bf16_t* KDT = (const bf16_t*)(item + 32768);
    const bf16_t* UT = (const bf16_t*)(item + 49152); const bf16_t* AQK = (const bf16_t*)(item + 65536);
#pragma unroll
    for (int s = 0; s < 4; ++s) { o.wf[s] = *(const bf16x8*)(Wg + (16 * w + lr) * 128 + 32 * s + 8 * lg); o.qf[s] = *(const bf16x8*)(QD + (16 * w + lr) * 128 + 32 * s + 8 * lg); }
#pragma unroll
    for (int s = 0; s < 2; ++s) o.af[s] = *(const bf16x8*)(AQK + (16 * w + lr) * 64 + 32 * s + 8 * lg);
#pragma unroll
    for (int dt = 0; dt < 2; ++dt)
#pragma unroll
        for (int s = 0; s < 2; ++s) o.kf[dt][s] = *(const bf16x8*)(KDT + (32 * w + 16 * dt + lr) * 64 + 32 * s + 8 * lg);
#pragma unroll
    for (int et = 0; et < 2; ++et) o.uu[et] = *(const u32x2*)(UT + (e0 + 16 * et + lr) * 64 + 16 * w + 4 * lg);
    o.egl = ((const float*)(ws + OFF_EXPGL))[hd * 256 + n];
}
template <bool FAKE> __device__ __forceinline__ void gdn_scan(const Params& p, int hd, int es, unsigned char* lds) {
    unsigned char* ws = lptr(p.ws);
    bf16_t* ST = (bf16_t*)lds;
    bf16_t* VN = ST + 32 * 136;
    bf16_t* OB = VN + 32 * 72;
    const int tid = ltid(), lane = tid & 63, w = tid >> 6, lr = lane & 15, lg = lane >> 4;
    const int e0 = es * 32;
    for (int i = tid; i < 32 * 136 / 2; i += 256) ((unsigned*)ST)[i] = 0u;
    f32x4 Sacc[2][2];
#pragma unroll
    for (int a = 0; a < 2; ++a)
#pragma unroll
        for (int b = 0; b < 2; ++b) Sacc[a][b] = (f32x4){0.f, 0.f, 0.f, 0.f};
    ScanOps cur, nxt;
    scan_load(cur, ws, hd, 0, e0, w, lr, lg);
    __syncthreads();
    constexpr int NMASK = FAKE ? 0 : 255;
    for (int n = 0; n < 256; ++n) {
        scan_load(nxt, ws, hd, (n < 255 ? n + 1 : 255) & NMASK, e0, w, lr, lg);
        f32x4 p1[2], p2[2];
#pragma unroll
        for (int et = 0; et < 2; ++et) { p1[et] = (f32x4){0.f, 0.f, 0.f, 0.f}; p2[et] = (f32x4){0.f, 0.f, 0.f, 0.f}; }
#pragma unroll
        for (int s = 0; s < 4; ++s)
#pragma unroll
            for (int et = 0; et < 2; ++et) { const bf16x8 sb = *(const bf16x8*)(ST + (16 * et + lr) * 136 + 32 * s + 8 * lg);
                p1[et] = mfma16(cur.wf[s], sb, p1[et]); p2[et] = mfma16(cur.qf[s], sb, p2[et]); }
#pragma unroll
        for (int et = 0; et < 2; ++et) {
            f32x4 v; v[0] = lo16(cur.uu[et].x) - p1[et][0]; v[1] = hi16(cur.uu[et].x) - p1[et][1]; v[2] = lo16(cur.uu[et].y) - p1[et][2]; v[3] = hi16(cur.uu[et].y) - p1[et][3];
            *(u32x2*)(VN + (16 * et + lr) * 72 + 16 * w + 4 * lg) = pack4(v);
        }
        LDS_BARRIER();
#pragma unroll
        for (int a = 0; a < 2; ++a)
#pragma unroll
            for (int b = 0; b < 2; ++b) Sacc[a][b] = Sacc[a][b] * cur.egl;
#pragma unroll
        for (int s = 0; s < 2; ++s)
#pragma unroll
            for (int et = 0; et < 2; ++et) { const bf16x8 vb = *(const bf16x8*)(VN + (16 * et + lr) * 72 + 32 * s + 8 * lg);
                Sacc[0][et] = mfma16(cur.kf[0][s], vb, Sacc[0][et]); Sacc[1][et] = mfma16(cur.kf[1][s], vb, Sacc[1][et]);
                p2[et] = mfma16(cur.af[s], vb, p2[et]); }
#pragma unroll
        for (int dt = 0; dt < 2; ++dt)
#pragma unroll
            for (int et = 0; et < 2; ++et) *(u32x2*)(ST + (16 * et + lr) * 136 + 32 * w + 16 * dt + 4 * lg) = pack4(Sacc[dt][et]);
#pragma unroll
        for (int et = 0; et < 2; ++et) *(u32x2*)(OB + ((n & 7) * 32 + 16 * et + lr) * 72 + 16 * w + 4 * lg) = pack4(p2[et]);
        LDS_BARRIER();
        if (!FAKE && (n & 7) == 7) {
            const int fe = tid >> 3, fch = tid & 7;
#pragma unroll
            for (int sl = 0; sl < 8; ++sl) {
                const u32x4 v = *(const u32x4*)(OB + (sl * 32 + fe) * 72 + fch * 8);
                *(u32x4*)((bf16_t*)(ws + OFF_GDN + (size_t)(hd * 256 + n - 7 + sl) * GDN_ITEM + 49152) + (e0 + fe) * 64 + fch * 8) = v;
            }
            if (tid == 0) __hip_atomic_store((unsigned*)(ws + OFF_CTR) + 32 + hd * 4 + es, (unsigned)(n + 1), __ATOMIC_RELAXED, __HIP_MEMORY_SCOPE_AGENT);
        }
        cur = nxt;
    }
    __syncthreads();
}

__device__ __forceinline__ void phase_c(const Params& p, int layer, unsigned char* lds) {
    unsigned char* ws = lptr(p.ws);
    unsigned* ctr = (unsigned*)(ws + OFF_CTR);
    __shared__ unsigned s_item;
    for (;;) {
        __syncthreads();
        if (ltid() == 0) s_item = atomicAdd(ctr, 1u);
        __syncthreads();
        const unsigned it = s_item;
        if (it >= 1024u + 512u) break;
        if (it < 1024u) {
            const int qb = 127 - (int)(it >> 3), hd = it & 7;
            flash_item<64, true>((const bf16_t*)(ws + OFF_AQ) + hd * 64, 512, (const bf16_t*)(ws + OFF_AK) + hd * 64, 512,
                                 (const bf16_t*)(ws + OFF_AVT) + (size_t)hd * 64 * SEQ, SEQ, (const float*)(ws + OFF_F) + (size_t)hd * SEQ,
                                 qb * 128, 2 * qb + 2, 0.125f, sqrtf(__uint_as_float(__hip_atomic_load((const unsigned*)(ws + OFF_CTR) + 16 + hd, __ATOMIC_RELAXED, __HIP_MEMORY_SCOPE_AGENT))), (bf16_t*)(ws + OFF_SZ) + hd * 64, 512, lds);
        } else {
            const int j = it - 1024, qb = j >> 2, mh = j & 3;
            flash_item<128, false>((const bf16_t*)(ws + OFF_MQ) + mh * 128, 512, (const bf16_t*)(ws + OFF_MK) + mh * 128, 512,
                                   (const bf16_t*)(ws + OFF_MVT) + (size_t)mh * 128 * 256, 256, nullptr,
                                   qb * 128, 4, 0.08838834764831845f, 0.f, (bf16_t*)(ws + OFF_SZ) + (size_t)2 * SEQ * 512 + mh * 128, 512, lds);
        }
    }
}

__device__ __forceinline__ void phase_e(const Params& p, int layer, unsigned char* lds) {
    unsigned char* ws = lptr(p.ws);
    const int tid = ltid(), bid = lbid(), nb = gridDim.x;
    bf16_t* T = (bf16_t*)lds;
    float* PS = (float*)(lds + 16640);
    float* RS = PS + 256;
    bf16_t* SZB = (bf16_t*)(ws + OFF_SZ) + (size_t)SEQ * 512;
    const float* gg = p.gdn_norm_g + layer * 128;
    for (int it = bid; it < 1024; it += nb) {
        const int hd = it >> 8, n = it & 255;
        const bf16_t* OT = (const bf16_t*)(ws + OFF_GDN + (size_t)it * GDN_ITEM + 49152);
        { const int c = tid & 63, eq = tid >> 6; float ss = 0.f;
#pragma unroll 8
          for (int j = 0; j < 32; ++j) { const int e = eq * 32 + j; const bf16_t v = OT[e * 64 + c]; T[c * 130 + e] = v; const float f = bf2f(v); ss += f * f; }
          PS[eq * 64 + c] = ss; }
        __syncthreads();
        if (tid < 64) RS[tid] = rsqrtf((PS[tid] + PS[64 + tid] + PS[128 + tid] + PS[192 + tid]) * (1.0f / 128.0f) + EPSV);
        __syncthreads();
        { const int row = tid >> 2, ec = (tid & 3) * 32; const float rstd = RS[row];
          bf16_t* Y = SZB + (size_t)(n * 64 + row) * 512 + hd * 128 + ec;
#pragma unroll
          for (int k = 0; k < 4; ++k) { u32x4 z = *(const u32x4*)(Y + 8 * k);
#pragma unroll
              for (int q = 0; q < 4; ++q) { const int e = ec + 8 * k + 2 * q;
                  z[q] = pack2(bf2f(T[row * 130 + e]) * rstd * gg[e] * lo16(z[q]), bf2f(T[row * 130 + e + 1]) * rstd * gg[e + 1] * hi16(z[q])); }
              *(u32x4*)(Y + 8 * k) = z; } }
        __syncthreads();
    }
}

template <int MODE>
__device__ __forceinline__ void phase_d1(const Params& p, int layer, unsigned char* lds, int b0) {
    unsigned char* ws = lptr(p.ws); const int bid = lbid() - b0, nb = gridDim.x - b0;
    const bf16_t* H = (const bf16_t*)(ws + OFF_H); const bf16_t* WIN = (const bf16_t*)(ws + OFF_WIN); const bf16_t* WBR = (const bf16_t*)(ws + OFF_WBR);
    const bf16_t* Yb = (const bf16_t*)(ws + OFF_SZ);
    const float* bm = p.b_merge + layer * 3072;
    bf16_t* MG = (bf16_t*)(ws + OFF_MERGED);
    for (int it = bid; it < 1024; it += nb) {
        const int mt = it >> 3, nt = it & 7;
        f32x4 mg[4][4];
        if (MODE == 0) { ZERO_ACC(mg); }
        else { FOR_ACC(mg, { const u32x2 t_ = *(const u32x2*)(MG + (size_t)(mt * 128 + m) * DM + nt * 128 + n); v[0] = lo16(t_.x); v[1] = hi16(t_.x); v[2] = lo16(t_.y); v[3] = hi16(t_.y); }); }
#pragma unroll 1
        for (int bi = 0; bi < (MODE == 0 ? 2 : 1); ++bi) {
            const int br = MODE == 0 ? 2 * bi : 1;
            f32x4 acc[4][4]; ZERO_ACC(acc);
            gemm_acc(H + (size_t)mt * 128 * DM, DM, WIN + (size_t)(5120 + br * 1024 + nt * 128) * DM, DM, DM, lds, acc);
            unsigned* GP = (unsigned*)(lds + 36864) + ltid();
            {
                const int lane_ = ltid() & 63, wid_ = ltid() >> 6, wc_ = wid_ & 1;
#pragma unroll
                for (int i_ = 0; i_ < 4; ++i_)
#pragma unroll
                    for (int j_ = 0; j_ < 4; ++j_) {
                        const int n = wc_ * 64 + j_ * 16 + 4 * (lane_ >> 4);
                        const f32x4 bv = *(const f32x4*)(bm + br * 1024 + nt * 128 + n);
                        const f32x4 v = acc[i_][j_];
                        GP[((i_ * 4 + j_) * 2 + 0) * 256] = pack2(sigmoidf_(v[0] + bv[0]), sigmoidf_(v[1] + bv[1]));
                        GP[((i_ * 4 + j_) * 2 + 1) * 256] = pack2(sigmoidf_(v[2] + bv[2]), sigmoidf_(v[3] + bv[3]));
                    }
            }
            ZERO_ACC(acc);
            gemm_acc(Yb + (size_t)br * SEQ * 512 + (size_t)mt * 128 * 512, 512, WBR + (size_t)br * 1024 * 512 + (size_t)nt * 128 * 512, 512, 512, lds, acc);
#pragma unroll
            for (int i_ = 0; i_ < 4; ++i_)
#pragma unroll
                for (int j_ = 0; j_ < 4; ++j_) {
                    const unsigned g0 = GP[((i_ * 4 + j_) * 2 + 0) * 256], g1 = GP[((i_ * 4 + j_) * 2 + 1) * 256];
                    mg[i_][j_][0] += lo16(g0) * acc[i_][j_][0]; mg[i_][j_][1] += hi16(g0) * acc[i_][j_][1];
                    mg[i_][j_][2] += lo16(g1) * acc[i_][j_][2]; mg[i_][j_][3] += hi16(g1) * acc[i_][j_][3];
                }
        }
        FOR_ACC(mg, { *(u32x2*)(MG + (size_t)(mt * 128 + m) * DM + nt * 128 + n) = pack4(v); });
    }
}

__device__ __forceinline__ void phase_d2(const Params& p, int layer, unsigned char* lds) {
    unsigned char* ws = lptr(p.ws); const int bid = lbid(), nb = gridDim.x;
    const bf16_t* MG = (const bf16_t*)(ws + OFF_MERGED); const bf16_t* WO = (const bf16_t*)(ws + OFF_WOUT);
    const float* xin = layer == 0 ? p.x : p.out;
    for (int it = bid; it < 1024; it += nb) {
        const int mt = it >> 3, nt = it & 7;
        f32x4 acc[4][4]; ZERO_ACC(acc);
        gemm_acc(MG + (size_t)mt * 128 * DM, DM, WO + (size_t)nt * 128 * DM, DM, DM, lds, acc);
        FOR_ACC(acc, { const size_t off = (size_t)(mt * 128 + m) * DM + nt * 128 + n; const f32x4 xv = *(const f32x4*)(xin + off); *(f32x4*)(p.out + off) = xv + v; });
    }
}

__device__ __forceinline__ void sub_barrier(const Params& p, int word, unsigned target) {
    unsigned* ctr = (unsigned*)(lptr(p.ws) + OFF_CTR) + word;
    __syncthreads();
    if (ltid() == 0) {
        __threadfence();
        __hip_atomic_fetch_add(ctr, 1u, __ATOMIC_RELAXED, __HIP_MEMORY_SCOPE_AGENT);
        while (__hip_atomic_load(ctr, __ATOMIC_RELAXED, __HIP_MEMORY_SCOPE_AGENT) < target) __builtin_amdgcn_s_sleep(4);
        __threadfence();
    }
    __syncthreads();
}

__device__ __forceinline__ void phase_final(const Params& p) {
#if PROBE_IDX >= 0
    __threadfence(); __syncthreads();
#endif
    const int tid = ltid(), lane = tid & 63, wid = tid >> 6;
    f32x4 g[4];
#pragma unroll
    for (int i = 0; i < 4; ++i) g[i] = *(const f32x4*)(p.final_norm_g + 4 * lane + 256 * i);
    for (int row = lbid() * 4 + wid; row < SEQ; row += gridDim.x * 4) {
        f32x4 xv[4]; float ss = 0.f;
#pragma unroll
        for (int i = 0; i < 4; ++i) { xv[i] = *(const f32x4*)(p.out + (size_t)row * DM + 4 * lane + 256 * i); ss += xv[i][0] * xv[i][0] + xv[i][1] * xv[i][1] + xv[i][2] * xv[i][2] + xv[i][3] * xv[i][3]; }
        ss = wave_sum(ss);
        const float rstd = rsqrtf(ss * (1.0f / DM) + EPSV);
#pragma unroll
        for (int i = 0; i < 4; ++i) {
            f32x4 ov = xv[i] * rstd * g[i];
#if PROBE_IDX >= 0
            if (lbid() == 0) {
                const unsigned long long* TS = (const unsigned long long*)(p.ws + OFF_TS);
#if PROBE_IDX == 24
                const unsigned long long d = (TS[24] - TS[5]) + (TS[25] - TS[13]);
#elif PROBE_IDX == 22
                const unsigned long long d = (TS[22] - TS[20]) + (TS[23] - TS[21]);
#elif PROBE_IDX == 20
                const unsigned long long d = (TS[20] - TS[4]) + (TS[21] - TS[12]);
#else
                const unsigned long long d = (TS[PROBE_IDX + 1] - TS[PROBE_IDX]) + (TS[8 + PROBE_IDX + 1] - TS[8 + PROBE_IDX]);
#endif
                const long long K = (long long)(d / 8ull);
                const long long seq = (long long)((row >> 11) * 4 + wid) * 1024;
#pragma unroll
                for (int q = 0; q < 4; ++q) if (seq + 4 * lane + 256 * i + q < K) ov[q] += 0.0625f;
            }
#endif
            *(f32x4*)(p.out + (size_t)row * DM + 4 * lane + 256 * i) = ov;
        }
    }
}

#if PROBE_IDX == 24
#define PROBE_SOLO(layer) do { if (lbid() == 0) { gdn_scan<true>(p, 0, 0, lds); if (ltid() == 0) ((unsigned long long*)(p.ws + OFF_TS))[24 + layer] = __builtin_amdgcn_s_memrealtime(); } grid.sync(); } while (0)
#else
#define PROBE_SOLO(layer) do { } while (0)
#endif
#define LAYER_BODY(layer) do { \
        TSTAMP(layer * 8 + 0); \
        phase_a(p, layer, lds); \
        grid.sync(); \
        TSTAMP(layer * 8 + 1); \
        phase_b1(p, lds); \
        grid.sync(); \
        TSTAMP(layer * 8 + 2); \
        for (int it = lbid(); it < 1024; it += gridDim.x) gdn_chunk(p, layer, it >> 8, it & 255, lds); \
        grid.sync(); \
        TSTAMP(layer * 8 + 3); \
        if (lbid() < 16) { gdn_scan<false>(p, lbid() >> 2, lbid() & 3, lds); } \
        else { \
            phase_b2(p, lds, 16); \
            sub_barrier(p, 48, gridDim.x - 16); \
            phase_c(p, layer, lds); \
            sub_barrier(p, 49, gridDim.x - 16); \
            phase_d1<0>(p, layer, lds, 16); \
        } \
        grid.sync(); \
        TSTAMP(layer * 8 + 4); \
        phase_e(p, layer, lds); \
        grid.sync(); \
        TSTAMP(layer * 8 + 5); \
        phase_d1<1>(p, layer, lds, 0); \
        grid.sync(); \
        TSTAMP(layer * 8 + 6); \
        phase_d2(p, layer, lds); \
        grid.sync(); \
        TSTAMP(layer * 8 + 7); \
} while (0)
__global__ void __launch_bounds__(256, 2) fwd_megakernel(Params p) {
    __shared__ __attribute__((aligned(16))) unsigned char lds[LDS_BYTES];
    cg::grid_group grid = cg::this_grid();
    LAYER_BODY(0);
    LAYER_BODY(1);
    phase_final(p);
}

extern "C" void kernel_launch(void* const* d_in, const int* in_sizes, int n_in, void* d_out, int out_size, void* d_ws, size_t ws_size, hipStream_t stream) {
    static int grid_blocks = 0;
    if (!grid_blocks) {
        int dev = 0, cus = 0, per_cu = 0;
        hipGetDevice(&dev);
        hipDeviceGetAttribute(&cus, hipDeviceAttributeMultiprocessorCount, dev);
        hipOccupancyMaxActiveBlocksPerMultiprocessor(&per_cu, fwd_megakernel, 256, 0);
        if (per_cu > 2) per_cu = 2;
        if (per_cu < 1) per_cu = 1;
        grid_blocks = cus * per_cu;
    }
    Params p{};
    p.x = (const float*)d_in[0]; p.mem = (const float*)d_in[1]; p.norm_g = (const float*)d_in[2]; p.w_in = (const float*)d_in[3];
    p.b_fg = (const float*)d_in[4]; p.b_merge = (const float*)d_in[5]; p.conv_w = (const float*)d_in[6]; p.a_log = (const float*)d_in[7];
    p.dt_bias = (const float*)d_in[8]; p.gdn_norm_g = (const float*)d_in[9]; p.mem_norm_g = (const float*)d_in[10]; p.w_mem_kv = (const float*)d_in[11];
    p.w_branch = (const float*)d_in[12]; p.w_out = (const float*)d_in[13]; p.final_norm_g = (const float*)d_in[14];
    p.out = (float*)d_out; p.ws = (unsigned char*)d_ws;
    void* args[] = {&p};
    hipError_t e = hipLaunchCooperativeKernel((void*)fwd_megakernel, dim3(grid_blocks), dim3(256), args, 0, stream);
    if (e != hipSuccess) fprintf(stderr, "cooperative launch failed: %s (grid %d)\n", hipGetErrorString(e), grid_blocks);
}
```
